# Optimizing an MI355X kernel written in HIP

```python
import math
import jax, jax.numpy as jnp
from jax import lax
import numpy as np

D_MODEL = 1024
BATCH = 1
SEQ = 16384
DEPTH = 1
DEC_BATCH = 32
DEC_SEQ = 32
PAST_LEN = 2048

CHUNK = 64
D_MIX = D_MODEL
D_CONV = D_MIX // 2
CONV_W = 3
N_HEADS = 4
HEAD_DIM = (D_MIX - D_CONV) // N_HEADS // 2
V_DIM = 2 * HEAD_DIM
QK_W = N_HEADS * 2 * HEAD_DIM
V_W = N_HEADS * V_DIM
IN_COLS = 3 * D_CONV + 2 * QK_W + V_W
SPLITS = (D_CONV, 2 * D_CONV, 3 * D_CONV, 3 * D_CONV + QK_W, 3 * D_CONV + 2 * QK_W)
D_FF = 4 * D_MODEL
PLE_DIM = 256
Q_BLOCK = 128
NEG_INF = -1e30
RMS_EPS = 1e-6

kernel_name = "hymba_conv_diffattn_streaming_step"


def rmsnorm(x, g):
    xf = x.astype(jnp.float32)
    y = xf * lax.rsqrt(jnp.mean(xf * xf, axis=-1, keepdims=True) + RMS_EPS)
    return (y * g.astype(jnp.float32)).astype(x.dtype)


def alibi_slopes():
    return 2.0 ** (-8.0 * jnp.arange(1, N_HEADS + 1, dtype=jnp.float32) / N_HEADS)


def diff_lambda(lq1, lk1, lq2, lk2, lam_init):
    f = jnp.float32
    return (jnp.exp(jnp.sum(lq1.astype(f) * lk1.astype(f)))
            - jnp.exp(jnp.sum(lq2.astype(f) * lk2.astype(f))) + lam_init)


def mix_inputs(h, w_in, g_pre):
    u = rmsnorm(h, g_pre)
    z = jnp.einsum('btd,de->bte', u, w_in)
    cb, cc, cx, q, k, v = jnp.split(z, SPLITS, axis=-1)
    b, t = h.shape[:2]
    q = q.reshape(b, t, N_HEADS, 2 * HEAD_DIM)
    k = k.reshape(b, t, N_HEADS, 2 * HEAD_DIM)
    v = v.reshape(b, t, N_HEADS, V_DIM)
    return cb, cc * cx, q, k, v


def short_conv(zc, hist, w_conv, b_conv):
    t = zc.shape[1]
    zp = jnp.concatenate([hist.astype(zc.dtype), zc], axis=1)
    y = b_conv + sum(zp[:, j:j + t] * w_conv[j] for j in range(CONV_W))
    return y, zp[:, -(CONV_W - 1):]


def diff_attn(q, k, v, q_pos, k_pos, lam, lam_init, g_subln):
    b, tq = q.shape[:2]
    tk = k.shape[1]
    f = jnp.float32
    qf = q.astype(f).reshape(b, tq, N_HEADS, 2, HEAD_DIM) * (HEAD_DIM ** -0.5)
    kf = k.astype(f).reshape(b, tk, N_HEADS, 2, HEAD_DIM)
    s = jnp.einsum('bqhmd,bkhmd->bhmqk', qf, kf)
    dist = jnp.abs(q_pos[:, None] - k_pos[None, :]).astype(f)
    bias = -alibi_slopes()[:, None, None] * dist
    visible = (k_pos[None, :] // CHUNK) <= (q_pos[:, None] // CHUNK)
    s = jnp.where(visible, s + bias[None, :, None], NEG_INF)
    a = jax.nn.softmax(s, axis=-1)
    attn = a[:, :, 0] - lam * a[:, :, 1]
    o = jnp.einsum('bhqk,bkhd->bqhd', attn, v.astype(f))
    o = rmsnorm(o, g_subln) * (1.0 - lam_init)
    return o.reshape(b, tq, V_W).astype(q.dtype)


def diff_attn_prompt(q, k, v, lam, lam_init, g_subln):
    b, t = q.shape[:2]
    nb = t // Q_BLOCK
    pos = jnp.arange(t, dtype=jnp.int32)
    qb = q.reshape(b, nb, Q_BLOCK, N_HEADS, 2 * HEAD_DIM).transpose(1, 0, 2, 3, 4)
    pb = pos.reshape(nb, Q_BLOCK)
    out = lax.map(lambda a: diff_attn(a[0], k, v, a[1], pos, lam, lam_init, g_subln), (qb, pb))
    return out.transpose(1, 0, 2, 3).reshape(b, t, V_W)


def finish(h, mix, p, w_out, g_post_mix, g_pre_mlp, w_up, w_down, g_post_mlp, w_pe, w_pe_gate, g_pe):
    h = h + rmsnorm(jnp.einsum('bte,ed->btd', mix, w_out), g_post_mix)
    u = rmsnorm(h, g_pre_mlp)
    ff = jnp.einsum('btf,fd->btd', jnp.square(jax.nn.relu(jnp.einsum('btd,df->btf', u, w_up))), w_down)
    h = h + rmsnorm(ff, g_post_mlp)
    e = jnp.einsum('btp,pd->btd', p, w_pe) * jax.nn.sigmoid(jnp.einsum('btd,de->bte', h, w_pe_gate))
    return h + rmsnorm(e, g_pe)


def setup_inputs(seed: int = 0) -> dict:
    key = jax.random.key(seed)
    ks = jax.random.split(key, 25)
    f = jnp.float32

    def nrm(k, shape, scale):
        return jax.random.normal(k, shape, f) * scale

    def gain(k, shape):
        return 1.0 + 0.05 * jax.random.normal(k, shape, f)

    return {
        "x_prompt": nrm(ks[0], (BATCH, SEQ, D_MODEL), 1.0),
        "x_sample": nrm(ks[1], (DEC_BATCH, DEC_SEQ, D_MODEL), 1.0),
        "cache_k": nrm(ks[2], (DEPTH, DEC_BATCH, PAST_LEN, N_HEADS, 2 * HEAD_DIM), 1.0),
        "cache_v": nrm(ks[3], (DEPTH, DEC_BATCH, PAST_LEN, N_HEADS, V_DIM), 1.0),
        "state_conv": nrm(ks[4], (DEPTH, DEC_BATCH, CONV_W - 1, D_CONV), 1.0),
        "p_prompt": nrm(ks[5], (DEPTH, BATCH, SEQ, PLE_DIM), 1.0),
        "p_sample": nrm(ks[6], (DEPTH, DEC_BATCH, DEC_SEQ, PLE_DIM), 1.0),
        "w_in": nrm(ks[7], (DEPTH, D_MODEL, IN_COLS), D_MODEL ** -0.5),
        "w_conv": nrm(ks[8], (DEPTH, CONV_W, D_CONV), CONV_W ** -0.5),
        "b_conv": nrm(ks[9], (DEPTH, D_CONV), 0.02),
        "lambda_q1": nrm(ks[10], (DEPTH, HEAD_DIM), 0.1),
        "lambda_k1": nrm(ks[11], (DEPTH, HEAD_DIM), 0.1),
        "lambda_q2": nrm(ks[12], (DEPTH, HEAD_DIM), 0.1),
        "lambda_k2": nrm(ks[13], (DEPTH, HEAD_DIM), 0.1),
        "g_subln": gain(ks[14], (DEPTH, V_DIM)),
        "w_out": nrm(ks[15], (DEPTH, D_MIX, D_MODEL), D_MIX ** -0.5),
        "g_pre_mix": gain(ks[16], (DEPTH, D_MODEL)),
        "g_post_mix": gain(ks[17], (DEPTH, D_MODEL)),
        "g_pre_mlp": gain(ks[18], (DEPTH, D_MODEL)),
        "g_post_mlp": gain(ks[19], (DEPTH, D_MODEL)),
        "w_up": nrm(ks[20], (DEPTH, D_MODEL, D_FF), D_MODEL ** -0.5),
        "w_down": nrm(ks[21], (DEPTH, D_FF, D_MODEL), D_FF ** -0.5),
        "w_pe": nrm(ks[22], (DEPTH, PLE_DIM, D_MODEL), PLE_DIM ** -0.5),
        "w_pe_gate": nrm(ks[23], (DEPTH, D_MODEL, D_MODEL), D_MODEL ** -0.5),
        "g_pe": gain(ks[24], (DEPTH, D_MODEL)),
    }


def reference(x_prompt, x_sample, cache_k, cache_v, state_conv, p_prompt, p_sample,
              w_in, w_conv, b_conv, lambda_q1, lambda_k1, lambda_q2, lambda_k2, g_subln,
              w_out, g_pre_mix, g_post_mix, g_pre_mlp, g_post_mlp, w_up, w_down,
              w_pe, w_pe_gate, g_pe):
    hp, hs = x_prompt, x_sample
    kp_l, vp_l, cp_l, ks_l, vs_l, cs_l = [], [], [], [], [], []
    t_s = x_sample.shape[1]
    q_pos_s = PAST_LEN + jnp.arange(t_s, dtype=jnp.int32)
    k_pos_s = jnp.arange(PAST_LEN + t_s, dtype=jnp.int32)
    for i in range(DEPTH):
        lam_init = 0.8 - 0.6 * math.exp(-0.3 * i)
        lam = diff_lambda(lambda_q1[i], lambda_k1[i], lambda_q2[i], lambda_k2[i], lam_init)
        rest = (w_out[i], g_post_mix[i], g_pre_mlp[i], w_up[i], w_down[i], g_post_mlp[i],
                w_pe[i], w_pe_gate[i], g_pe[i])

        cb, zc, q, k, v = mix_inputs(hp, w_in[i], g_pre_mix[i])
        hist0 = jnp.zeros((hp.shape[0], CONV_W - 1, D_CONV), zc.dtype)
        yc, conv_p = short_conv(zc, hist0, w_conv[i], b_conv[i])
        ya = diff_attn_prompt(q, k, v, lam, lam_init, g_subln[i])
        mix = jnp.concatenate([cb * yc, ya.astype(yc.dtype)], axis=-1)
        hp = finish(hp, mix, p_prompt[i], *rest)
        kp_l.append(k); vp_l.append(v); cp_l.append(conv_p)

        cb, zc, q, k, v = mix_inputs(hs, w_in[i], g_pre_mix[i])
        yc, conv_s = short_conv(zc, state_conv[i], w_conv[i], b_conv[i])
        k_all = jnp.concatenate([cache_k[i].astype(k.dtype), k], axis=1)
        v_all = jnp.concatenate([cache_v[i].astype(v.dtype), v], axis=1)
        ya = diff_attn(q, k_all, v_all, q_pos_s, k_pos_s, lam, lam_init, g_subln[i])
        mix = jnp.concatenate([cb * yc, ya.astype(yc.dtype)], axis=-1)
        hs = finish(hs, mix, p_sample[i], *rest)
        ks_l.append(k); vs_l.append(v); cs_l.append(conv_s)

    k_prompt = jnp.stack(kp_l); v_prompt = jnp.stack(vp_l); conv_prompt = jnp.stack(cp_l)
    k_sample = jnp.stack(ks_l); v_sample = jnp.stack(vs_l); conv_sample = jnp.stack(cs_l)
    return (hp, hs, k_prompt, v_prompt, conv_prompt, k_sample, v_sample, conv_sample)
```

```cpp
#include <hip/hip_runtime.h>
#include <hip/hip_cooperative_groups.h>
#include <cstdio>
#include <cstdint>
namespace cg = cooperative_groups;
constexpr int DM = 1024, SEQP = 16384, NSB = 32, NST = 32, PASTL = 2048, NH = 4, DCONV = 512, NIN = 3072, DFF = 4096, PLE = 256;
constexpr int MP = SEQP, MS = NSB * NST, MT = MP + MS;
constexpr int COL_CB = 0, COL_CC = 512, COL_CX = 1024, COL_Q = 1536, COL_K = 2048, COL_V = 2560;
constexpr float RMS_EPS = 1e-6f, LAM_INIT = 0.2f, LOG2E = 1.4426950408889634f, QSCALE = 0.125f * 1.4426950408889634f;
constexpr size_t OFF_Y = 0, OFF_KP = (size_t)MT * DM, OFF_VP = OFF_KP + (size_t)MP * 512, OFF_CP = OFF_VP + (size_t)MP * 512,
                 OFF_KS = OFF_CP + 2 * 512, OFF_VS = OFF_KS + (size_t)MS * 512, OFF_CS = OFF_VS + (size_t)MS * 512, OUT_TOTAL = OFF_CS + (size_t)NSB * 2 * 512;
namespace pg8 {
#define PG8_LAS __attribute__((address_space(3)))
typedef unsigned short bf16_t;
typedef short bf16x8 __attribute__((ext_vector_type(8)));
typedef float f32x4 __attribute__((ext_vector_type(4)));
typedef unsigned u32x4 __attribute__((ext_vector_type(4)));
constexpr int BM = 256, BK = 64, HALF = 128, HTB = HALF * BK * 2  , STAGE_BYTES = 8 * HTB, NXCD = 8, WGM = 8;

__host__ __device__ __forceinline__ int lds_byte(int r, int c) { const int st = (r >> 4) * 2 + (c >> 5), rr = r & 15, cc = c & 31, ob = rr * 64 + cc * 2; return st * 1024 + (ob ^ (((ob >> 9) & 1) << 5)); }
__host__ __device__ __forceinline__ void stage_rc(int b, int& R, int& C) { const int st = b / 1024, sb = b % 1024, swz = sb ^ (((sb >> 9) & 1) << 5); R = (st >> 1) * 16 + swz / 64; C = (st & 1) * 32 + (swz % 64) / 2; }
__host__ __device__ __forceinline__ int perm32(int rho) { const int n = rho >> 4, i = rho & 15; return 8 * (i >> 2) + 4 * n + (i & 3); }

struct Unit { int pm, pn; };
struct Gemm { const bf16_t* A; const bf16_t* Bt; int M, N, K; };

struct StaticOrder {
    int nM, nN, nwg, G, c;
    __host__ __device__ void init(int M, int N, int G_, int c_) { nM = M / BM; nN = N / BM; nwg = nM * nN; G = G_; c = c_; }
    __host__ __device__ bool next(int i, Unit& u) const {
        const long L = (long)i * G + c; if (L >= nwg) return false;
        int wgid = (int)L; { const int q = nwg / NXCD, r = nwg % NXCD, xcd = wgid % NXCD, off = wgid / NXCD; wgid = (xcd < r ? xcd * (q + 1) : r * (q + 1) + (xcd - r) * q) + off; }
        const int nig = WGM * nN, gid = wgid / nig, fm = gid * WGM, gsz = (nM - fm) < WGM ? (nM - fm) : WGM;
        u.pm = fm + ((wgid % nig) % gsz); u.pn = (wgid % nig) / gsz; return true;
    }
    __device__ __forceinline__ void a_ready(const Unit&) const {}
    __device__ __forceinline__ void done(const Unit&) const {}
};

__device__ __forceinline__ unsigned cvt_pk_bf16(float lo, float hi) { unsigned r; asm volatile("v_cvt_pk_bf16_f32 %0, %1, %2" : "=v"(r) : "v"(lo), "v"(hi)); return r; }
typedef float f32x2 __attribute__((ext_vector_type(2)));
typedef unsigned u32x2 __attribute__((ext_vector_type(2)));
template <int ACT> struct EpiBf16 {
    static constexpr bool PERM = true, AFTER_DRAIN = false;
    bf16_t* O; int ldc;
    __device__ __forceinline__ void operator()(const f32x4 (&acc)[2][2][4][2], const Unit& u, int wr, int wc, int fr, int fq) const {
        const int row0 = u.pm * BM + wr * 64 + fr, col0 = u.pn * BM + wc * 32 + 8 * fq;
#pragma unroll
        for (int ai = 0; ai < 2; ++ai)
#pragma unroll
            for (int m = 0; m < 4; ++m) { bf16_t* rowp = O + (size_t)(row0 + ai * HALF + m * 16) * ldc + col0;
#pragma unroll
                for (int bj = 0; bj < 2; ++bj) { f32x4 v0 = acc[ai][bj][m][0], v1 = acc[ai][bj][m][1];
                    if (ACT == 2) {
#pragma unroll
                        for (int e = 0; e < 4; ++e) { const float a = fmaxf(v0[e], 0.f), b = fmaxf(v1[e], 0.f); v0[e] = a * a; v1[e] = b * b; } }
                    u32x4 w; w.x = cvt_pk_bf16(v0[0], v0[1]); w.y = cvt_pk_bf16(v0[2], v0[3]); w.z = cvt_pk_bf16(v1[0], v1[1]); w.w = cvt_pk_bf16(v1[2], v1[3]);
                    *(u32x4*)(rowp + bj * HALF) = w; } }
    }
};
struct EpiIn {
    static constexpr bool PERM = true, AFTER_DRAIN = false;
    bf16_t* Z; float* kout; float* vout;
    __device__ __forceinline__ void operator()(const f32x4 (&acc)[2][2][4][2], const Unit& u, int wr, int wc, int fr, int fq) const {
        const int row0 = u.pm * BM + wr * 64 + fr, colt = u.pn * BM, col0 = colt + wc * 32 + 8 * fq;
        const float sc = (u.pn == 6 || u.pn == 7) ? QSCALE : 1.f;
        float* fdst = nullptr;
        if (u.pn >= 8) { const bool isv = u.pn >= 10; fdst = (isv ? vout : kout) + (colt - (isv ? COL_V : COL_K) + wc * 32 + 8 * fq); }
#pragma unroll
        for (int ai = 0; ai < 2; ++ai)
#pragma unroll
            for (int m = 0; m < 4; ++m) { const int row = row0 + ai * HALF + m * 16; bf16_t* rowp = Z + (size_t)row * NIN + col0;
#pragma unroll
                for (int bj = 0; bj < 2; ++bj) { const f32x4 a0 = acc[ai][bj][m][0], a1 = acc[ai][bj][m][1]; const f32x4 v0 = a0 * sc, v1 = a1 * sc;
                    u32x4 w; w.x = cvt_pk_bf16(v0[0], v0[1]); w.y = cvt_pk_bf16(v0[2], v0[3]); w.z = cvt_pk_bf16(v1[0], v1[1]); w.w = cvt_pk_bf16(v1[2], v1[3]);
                    *(u32x4*)(rowp + bj * HALF) = w;
                    if (fdst) { float* fp = fdst + (size_t)row * 512 + bj * HALF; *(f32x4*)fp = a0; *(f32x4*)(fp + 4) = a1; } } }
    }
};
template <int MODE> struct EpiPre {
    static constexpr bool PERM = true, AFTER_DRAIN = false;
    bf16_t* C; const bf16_t* pe;
    __device__ __forceinline__ void operator()(const f32x4 (&acc)[2][2][4][2], const Unit& u, int wr, int wc, int fr, int fq) const {
        const int row0 = u.pm * BM + wr * 64 + fr, col0 = u.pn * BM + wc * 32 + 8 * fq;
#pragma unroll
        for (int ai = 0; ai < 2; ++ai)
#pragma unroll
            for (int m = 0; m < 4; ++m) { const size_t off = (size_t)(row0 + ai * HALF + m * 16) * DM + col0;
#pragma unroll
                for (int bj = 0; bj < 2; ++bj) { f32x4 v0 = acc[ai][bj][m][0], v1 = acc[ai][bj][m][1];
                    if (MODE == 1) { const u32x4 pw = *(const u32x4*)(pe + off + bj * HALF);
                        const float p[8] = {__uint_as_float(pw.x << 16), __uint_as_float(pw.x & 0xffff0000u), __uint_as_float(pw.y << 16), __uint_as_float(pw.y & 0xffff0000u),
                                            __uint_as_float(pw.z << 16), __uint_as_float(pw.z & 0xffff0000u), __uint_as_float(pw.w << 16), __uint_as_float(pw.w & 0xffff0000u)};
#pragma unroll
                        for (int e = 0; e < 4; ++e) { v0[e] = p[e] * __builtin_amdgcn_rcpf(1.f + __builtin_amdgcn_exp2f(-LOG2E * v0[e])); v1[e] = p[4 + e] * __builtin_amdgcn_rcpf(1.f + __builtin_amdgcn_exp2f(-LOG2E * v1[e])); } }
                    u32x4 w; w.x = cvt_pk_bf16(v0[0], v0[1]); w.y = cvt_pk_bf16(v0[2], v0[3]); w.z = cvt_pk_bf16(v1[0], v1[1]); w.w = cvt_pk_bf16(v1[2], v1[3]);
                    *(u32x4*)(C + off + bj * HALF) = w; } }
    }
};
template <class Epi, class Sched, bool ALIGN_EPI = false, bool SP2 = false>
__device__ __forceinline__ void gemm_phase(PG8_LAS unsigned char* lds, const Gemm g, const Sched& S, const Epi& E) {
    int tid = threadIdx.x; asm volatile("" : "+v"(tid));
    const int wid = __builtin_amdgcn_readfirstlane(tid >> 6), lane = tid & 63, wr = wid >> 2, wc = wid & 3, fr = lane & 15, fq = lane >> 4;
    const int K = g.K, nt = K / BK;
    unsigned voffA[2], voffB[2];
#pragma unroll
    for (int i = 0; i < 2; ++i) { int R, C; stage_rc(tid * 16 + i * 8192, R, C); const int Rb = Epi::PERM ? ((R & ~31) + perm32(R & 31)) : R;
        voffA[i] = (unsigned)(R * K + C) * 2u; voffB[i] = (unsigned)(Rb * K + C) * 2u; }
    const size_t kstep = (size_t)(BK * 2);
    const size_t hstep = (size_t)HALF * K * 2;
    const size_t tstep = 2 * hstep;
    const unsigned ldsw = (unsigned)wid * 1024u;
    const int aoff = lds_byte(wr * 64 + fr, fq * 8), boff = lds_byte(wc * 32 + fr, fq * 8);
#define PG8_SA(b, h) (((b) * 2 + (h)) * HTB)
#define PG8_SB(b, h) ((4 + (b) * 2 + (h)) * HTB)
#define PG8_STAGE(bufoff, gbase, voff) do { _Pragma("unroll") for (int _i = 0; _i < 2; ++_i) \
        __builtin_amdgcn_global_load_lds((const unsigned*)((const char*)(gbase) + (voff)[_i]), (PG8_LAS unsigned*)(lds + (bufoff) + ldsw + _i * 8192), 16, 0, 0); } while (0)
#define PG8_LDA(dst, b, h) do { _Pragma("unroll") for (int m = 0; m < 4; ++m) _Pragma("unroll") for (int k = 0; k < 2; ++k) dst[m][k] = *(const PG8_LAS bf16x8*)(lds + PG8_SA(b, h) + aoff + m * 2048 + k * 1024); } while (0)
#define PG8_LDB(dst, b, h) do { _Pragma("unroll") for (int n = 0; n < 2; ++n) _Pragma("unroll") for (int k = 0; k < 2; ++k) dst[n][k] = *(const PG8_LAS bf16x8*)(lds + PG8_SB(b, h) + boff + n * 2048 + k * 1024); } while (0)
#define PG8_MMA(ai, bj, At, Bt) do { __builtin_amdgcn_s_setprio(1); _Pragma("unroll") for (int m = 0; m < 4; ++m) _Pragma("unroll") for (int n = 0; n < 2; ++n) _Pragma("unroll") for (int k = 0; k < 2; ++k) \
        acc[ai][bj][m][n] = __builtin_amdgcn_mfma_f32_16x16x32_bf16(Bt[n][k], At[m][k], acc[ai][bj][m][n], 0, 0, 0); __builtin_amdgcn_s_setprio(0); } while (0)
#define PG8_WAIT_V(n) asm volatile("s_waitcnt vmcnt(" #n ")" ::: "memory")
#define PG8_WAIT_L(n) asm volatile("s_waitcnt lgkmcnt(" #n ")" ::: "memory")
#define PG8_BAR __builtin_amdgcn_s_barrier()
#define PG8_SCHED __builtin_amdgcn_sched_barrier(0)
    Unit cur, nxt; int ui = 0;
    if (!S.next(0, cur)) return;
    f32x4 acc[2][2][4][2];
#pragma unroll
    for (int a = 0; a < 2; ++a)
#pragma unroll
        for (int b = 0; b < 2; ++b)
#pragma unroll
            for (int m = 0; m < 4; ++m)
#pragma unroll
                for (int n = 0; n < 2; ++n) acc[a][b][m][n] = (f32x4){0.f, 0.f, 0.f, 0.f};
    bf16x8 At[4][2], B0[2][2], B1[2][2];
    const char* cA = (const char*)g.A + (size_t)cur.pm * tstep; const char* cB = (const char*)g.Bt + (size_t)cur.pn * tstep;
    S.a_ready(cur);
    if constexpr (SP2) {
        PG8_STAGE(PG8_SB(0, 0), cB, voffB); PG8_STAGE(PG8_SB(0, 1), cB + hstep, voffB); PG8_STAGE(PG8_SA(0, 0), cA, voffA); PG8_STAGE(PG8_SA(0, 1), cA + hstep, voffA);
        if (wr == 1) PG8_BAR;
        PG8_WAIT_V(2); PG8_BAR;
        PG8_STAGE(PG8_SB(1, 0), cB + kstep, voffB); PG8_STAGE(PG8_SA(1, 0), cA + kstep, voffA); PG8_STAGE(PG8_SB(1, 1), cB + hstep + kstep, voffB);
        PG8_WAIT_V(6); PG8_BAR;
    } else {
        PG8_STAGE(PG8_SB(0, 0), cB, voffB); PG8_STAGE(PG8_SA(0, 0), cA, voffA); PG8_STAGE(PG8_SB(0, 1), cB + hstep, voffB); PG8_STAGE(PG8_SA(0, 1), cA + hstep, voffA);
        if (wr == 1) PG8_BAR;
        PG8_WAIT_V(4); PG8_BAR;
        PG8_STAGE(PG8_SB(1, 0), cB + kstep, voffB); PG8_STAGE(PG8_SA(1, 0), cA + kstep, voffA); PG8_STAGE(PG8_SB(1, 1), cB + hstep + kstep, voffB);
        PG8_WAIT_V(6); PG8_BAR;
    }
    for (;;) {
        const bool has_next = S.next(ui + 1, nxt);
        const char* nA = has_next ? (const char*)g.A + (size_t)nxt.pm * tstep : cA; const char* nB = has_next ? (const char*)g.Bt + (size_t)nxt.pn * tstep : cB;
        for (int t = 0; t < nt; t += 2) {
            const bool last = (t == nt - 2);
            const char* a1 = cA + (size_t)(t + 1) * kstep;
            const char* a2 = last ? nA : cA + (size_t)(t + 2) * kstep; const char* b2 = last ? nB : cB + (size_t)(t + 2) * kstep;
            const char* a3 = a2 + kstep; const char* b3 = b2 + kstep;
            if (last && has_next) S.a_ready(nxt);
            if constexpr (SP2) {
            PG8_LDB(B0, 0, 0); PG8_LDB(B1, 0, 1); PG8_SCHED; PG8_LDA(At, 0, 0); PG8_STAGE(PG8_SA(1, 1), a1 + hstep, voffA);
            PG8_WAIT_V(8); PG8_WAIT_L(0); PG8_BAR; PG8_MMA(0, 0, At, B0); PG8_MMA(0, 1, At, B1); PG8_BAR; PG8_SCHED;
            PG8_LDA(At, 0, 1); PG8_STAGE(PG8_SB(0, 0), b2, voffB); PG8_STAGE(PG8_SB(0, 1), b2 + hstep, voffB); PG8_STAGE(PG8_SA(0, 0), a2, voffA);
            PG8_WAIT_V(8); PG8_WAIT_L(0); PG8_BAR; PG8_MMA(1, 0, At, B0); PG8_MMA(1, 1, At, B1); PG8_BAR; PG8_SCHED;
            PG8_LDB(B0, 1, 0); PG8_LDB(B1, 1, 1); PG8_SCHED; PG8_LDA(At, 1, 0); PG8_STAGE(PG8_SA(0, 1), a2 + hstep, voffA);
            PG8_WAIT_V(8); PG8_WAIT_L(0); PG8_BAR; PG8_MMA(0, 0, At, B0); PG8_MMA(0, 1, At, B1); PG8_BAR; PG8_SCHED;
            PG8_LDA(At, 1, 1); PG8_STAGE(PG8_SB(1, 0), b3, voffB); PG8_STAGE(PG8_SB(1, 1), b3 + hstep, voffB); PG8_STAGE(PG8_SA(1, 0), a3, voffA);
            PG8_WAIT_V(8); PG8_WAIT_L(0); PG8_BAR; PG8_MMA(1, 0, At, B0); PG8_MMA(1, 1, At, B1); PG8_BAR; PG8_SCHED;
            } else {
            PG8_LDB(B0, 0, 0); PG8_SCHED; PG8_LDA(At, 0, 0); PG8_STAGE(PG8_SA(1, 1), a1 + hstep, voffA);
            PG8_WAIT_L(8); PG8_BAR; PG8_WAIT_L(0); PG8_MMA(0, 0, At, B0); PG8_BAR; PG8_SCHED;
            PG8_LDB(B1, 0, 1); PG8_STAGE(PG8_SB(0, 0), b2, voffB);
            PG8_BAR; PG8_WAIT_L(0); PG8_MMA(0, 1, At, B1); PG8_BAR;
            PG8_LDA(At, 0, 1); PG8_STAGE(PG8_SA(0, 0), a2, voffA);
            PG8_BAR; PG8_WAIT_L(0); PG8_MMA(1, 0, At, B0); PG8_BAR; PG8_SCHED;
            PG8_STAGE(PG8_SB(0, 1), b2 + hstep, voffB);
            PG8_WAIT_V(6); PG8_BAR; PG8_MMA(1, 1, At, B1); PG8_BAR;
            PG8_LDB(B0, 1, 0); PG8_SCHED; PG8_LDA(At, 1, 0); PG8_STAGE(PG8_SA(0, 1), a2 + hstep, voffA);
            PG8_WAIT_L(8); PG8_BAR; PG8_WAIT_L(0); PG8_MMA(0, 0, At, B0); PG8_BAR; PG8_SCHED;
            PG8_LDB(B1, 1, 1); PG8_STAGE(PG8_SB(1, 0), b3, voffB);
            PG8_BAR; PG8_WAIT_L(0); PG8_MMA(0, 1, At, B1); PG8_BAR;
            PG8_LDA(At, 1, 1); PG8_STAGE(PG8_SA(1, 0), a3, voffA);
            PG8_BAR; PG8_WAIT_L(0); PG8_MMA(1, 0, At, B0); PG8_BAR; PG8_SCHED;
            PG8_STAGE(PG8_SB(1, 1), b3 + hstep, voffB);
            PG8_WAIT_V(6); PG8_BAR; PG8_MMA(1, 1, At, B1); PG8_BAR;
            }
        }
        if constexpr (ALIGN_EPI) { if (wr == 0) PG8_BAR; }
        if constexpr (!Epi::AFTER_DRAIN) { E(acc, cur, wr, wc, fr, fq); S.done(cur); }
        if (!has_next) break;
#pragma unroll
        for (int a = 0; a < 2; ++a)
#pragma unroll
            for (int b = 0; b < 2; ++b)
#pragma unroll
                for (int m = 0; m < 4; ++m)
#pragma unroll
                    for (int n = 0; n < 2; ++n) acc[a][b][m][n] = (f32x4){0.f, 0.f, 0.f, 0.f};
        cur = nxt; cA = nA; cB = nB; ++ui;
        if constexpr (ALIGN_EPI) { if (wr == 1) PG8_BAR; }
    }
    PG8_WAIT_V(0);
    if constexpr (!ALIGN_EPI) { if (wr == 0) PG8_BAR; }
    PG8_BAR;
    if constexpr (Epi::AFTER_DRAIN) { E.fused(acc, cur, wr, wc, fr, fq, lds, wid, lane); S.done(cur); }
#undef PG8_SA
#undef PG8_SB
#undef PG8_STAGE
#undef PG8_LDA
#undef PG8_LDB
#undef PG8_MMA
#undef PG8_WAIT_V
#undef PG8_WAIT_L
#undef PG8_BAR
#undef PG8_SCHED
}
}
#define PG8_SP2 true
#define PG8_ALIGN true

constexpr size_t MiB = 1u << 20;
constexpr size_t WS_CTL = 0, CTL_ZERO_BYTES = 64 * 1024;
constexpr size_t WS_WIN = 1 * MiB, WS_WOUT = 7 * MiB, WS_WUP = 9 * MiB, WS_WDN = 17 * MiB, WS_WG = 25 * MiB, WS_WPE = 27 * MiB;
constexpr size_t WS_SSQ = 28 * MiB;
constexpr size_t WS_ACT = 30 * MiB;
constexpr size_t WS_PBF = 64 * MiB;
constexpr size_t WS_PE = 73 * MiB;
constexpr size_t WS_O1 = 107 * MiB;
constexpr size_t WS_H1 = 175 * MiB;
constexpr size_t WS_Z = 243 * MiB;
constexpr size_t WS_CK = 345 * MiB, WS_CV = 409 * MiB;
constexpr size_t WS_F = WS_Z;
constexpr size_t WS_PART = 379 * MiB;
constexpr size_t WS_END = 480 * MiB;
static_assert(WS_F + (size_t)MT * DFF * 2 <= WS_PART && WS_PART + (size_t)768 * 8 * 66 * 64 * 4 <= WS_END, "KV-split partial slots");
static_assert(WS_ACT + (size_t)MT * DM * 2 <= WS_PBF && WS_PBF + (size_t)MT * PLE * 2 <= WS_PE && WS_PE + (size_t)MT * DM * 2 <= WS_O1 && WS_O1 + (size_t)MT * DM * 4 <= WS_H1 &&
              WS_H1 + (size_t)MT * DM * 4 <= WS_Z && WS_Z + (size_t)MT * NIN * 2 <= WS_CK && WS_CK + (size_t)NSB * PASTL * 512 * 2 <= WS_CV && WS_CV + (size_t)NSB * PASTL * 512 * 2 <= WS_END && WS_F + (size_t)MT * DFF * 2 <= WS_CV && WS_SSQ + (size_t)MT * 64 <= WS_ACT, "d_ws map");
constexpr int CW_BAR = 1024, CW_QUEUE = 64, CW_NRM = 128, CW_ECNT = 8192;

constexpr int RING_OFF = 0, RING_BYTES = 131072;
constexpr int LDSCTL_OFF = RING_BYTES, MISC_OFF = LDSCTL_OFF + 320;
constexpr int LDS_BYTES = 147456;
constexpr int NWAVES = 8;

#define GAS __attribute__((address_space(1)))
#define LAS __attribute__((address_space(3)))
typedef unsigned short bf16;
typedef unsigned v4u __attribute__((ext_vector_type(4)));
typedef unsigned v2u __attribute__((ext_vector_type(2)));
typedef float f32x4 __attribute__((ext_vector_type(4)));
typedef short bf16x8 __attribute__((ext_vector_type(8)));
typedef short s16x4 __attribute__((ext_vector_type(4)));
typedef float f32x16 __attribute__((ext_vector_type(16)));
#define LDS_WAIT() asm volatile("s_waitcnt lgkmcnt(0)" ::: "memory")
__device__ __forceinline__ unsigned f2bf(float f) { unsigned u = __builtin_bit_cast(unsigned, f); return (u + 0x7fffu + ((u >> 16) & 1u)) >> 16; }
typedef __bf16 bf2_t __attribute__((ext_vector_type(2)));
typedef float f32x2_t __attribute__((ext_vector_type(2)));
__device__ __forceinline__ unsigned pk2(float lo, float hi) { const f32x2_t v = {lo, hi}; return __builtin_bit_cast(unsigned, __builtin_convertvector(v, bf2_t)); }
__device__ __forceinline__ float bflo(unsigned w) { return __uint_as_float(w << 16); }
__device__ __forceinline__ float bfhi(unsigned w) { return __uint_as_float(w & 0xffff0000u); }

#define XB_TMO      128
#define XB_XCNT(j)  (256  + 64 * (j))
#define XB_XSUB(j)  (1280 + 64 * (j))
#define XB_XGEN(j)  (2304 + 64 * (j))
#define XB_TOP      3328
#define XB_TOPGEN   3392
#define XCD_BAR_WORDS 3456
#define XB_SPIN_CAP (1u << 18)

__device__ __forceinline__ unsigned xb_ld(unsigned* p)              { return __hip_atomic_load(p, __ATOMIC_RELAXED, __HIP_MEMORY_SCOPE_AGENT); }
__device__ __forceinline__ unsigned xb_add(unsigned* p, unsigned v) { return __hip_atomic_fetch_add(p, v, __ATOMIC_RELAXED, __HIP_MEMORY_SCOPE_AGENT); }
__device__ __forceinline__ unsigned xb_xcc_id() { return (unsigned)__builtin_amdgcn_s_getreg((3 << 11) | 20) & 0xFu; }
#define XB_SPIN(cond, bar) do { unsigned _sp = 0; while (cond) { __builtin_amdgcn_s_sleep(1); \
    if ((++_sp & 255u) == 0u) { if (xb_ld(&(bar)[XB_TMO])) break; if (_sp > XB_SPIN_CAP) { atomicAdd(&(bar)[XB_TMO], 1u); break; } } } } while (0)

struct XcdBarrier {
    unsigned* bar; unsigned x;
    volatile LAS unsigned* st;
};

__device__ __forceinline__ XcdBarrier xcd_barrier_post(unsigned* bar, volatile LAS unsigned* st) {
    XcdBarrier b; b.bar = bar; b.x = xb_xcc_id(); b.st = st;
    if (threadIdx.x == 0) (void)xb_add(&bar[XB_XCNT(b.x)], 1u);
    return b;
}
__device__ __forceinline__ void xcd_barrier_complete(unsigned* bar, unsigned x, unsigned& nloc, unsigned& nx) {
    const unsigned G = gridDim.x * gridDim.y * gridDim.z;
    unsigned sum, cnt, mine, sp = 0u;
    for (;;) {
        sum = 0u; cnt = 0u; mine = 0u;
#pragma unroll
        for (unsigned j = 0; j < 16; ++j) { const unsigned c = xb_ld(&bar[XB_XCNT(j)]); sum += c; cnt += (c > 0u) ? 1u : 0u; mine = (j == x) ? c : mine; }
        if (sum == G) break;
        __builtin_amdgcn_s_sleep(1);
        if ((++sp & 255u) == 0u) { if (xb_ld(&bar[XB_TMO])) break; if (sp > XB_SPIN_CAP) { atomicAdd(&bar[XB_TMO], 1u); break; } }
    }
    nloc = mine > 0u ? mine : 1u; nx = cnt > 0u ? cnt : 1u;
}

__device__ __forceinline__ void xcd_barrier(const XcdBarrier& b) {
    asm volatile("s_waitcnt vmcnt(0)" ::: "memory");
    __syncthreads();
    if (threadIdx.x == 0) {
        unsigned* bar = b.bar;
        __builtin_amdgcn_s_waitcnt(0);
        unsigned nloc = b.st[0], nx = b.st[1];
        if (nloc == 0u) { xcd_barrier_complete(bar, b.x, nloc, nx); b.st[0] = nloc; b.st[1] = nx; }
        const unsigned old = xb_add(&bar[XB_XSUB(b.x)], 1u);
        const unsigned gen = old / nloc;
        if (old + 1u == (gen + 1u) * nloc) {
            __builtin_amdgcn_fence(__ATOMIC_RELEASE, "agent");
            asm volatile("s_waitcnt vmcnt(0)" ::: "memory");
            const unsigned og = xb_add(&bar[XB_TOP], 1u);
            const unsigned tg = og / nx;
            if (og + 1u == (tg + 1u) * nx) xb_add(&bar[XB_TOPGEN], 1u);
            else XB_SPIN(xb_ld(&bar[XB_TOPGEN]) == tg, bar);
            __builtin_amdgcn_fence(__ATOMIC_ACQUIRE, "agent");
            xb_add(&bar[XB_XGEN(b.x)], 1u);
            asm volatile("s_waitcnt vmcnt(0)" ::: "memory");
        } else {
            XB_SPIN(xb_ld(&bar[XB_XGEN(b.x)]) == gen, bar);
            __builtin_amdgcn_fence(__ATOMIC_ACQUIRE, "agent");
            asm volatile("s_waitcnt vmcnt(0)" ::: "memory");
        }
    }
    __syncthreads();
}


struct Args { const float* in[25]; float* out; unsigned char* ws; };

__device__ __forceinline__ float wave_sum(float v) {
#pragma unroll
    for (int o = 1; o < 64; o <<= 1) v += __shfl_xor(v, o);
    return v;
}
__device__ __forceinline__ float swap32(float v) { return __shfl_xor(v, 32); }

__device__ __forceinline__ void p0_transpose_item(const float* W, int K, int N, bf16* WT, LAS float* scr, int item, int lane) {
    const int nblk = N / 32, kb = item / nblk, nb = item % nblk, k0 = 64 * kb, n0 = 32 * nb;
#pragma unroll 8
    for (int i = 0; i < 32; ++i) { const int kk = 2 * i + (lane >> 5); scr[kk * 33 + (lane & 31)] = W[(size_t)(k0 + kk) * N + n0 + (lane & 31)]; }
    LDS_WAIT(); asm volatile("" ::: "memory");
    const int c = lane & 7;
#pragma unroll
    for (int j = 0; j < 4; ++j) { const int n = (lane >> 3) + 8 * j; const LAS float* s = scr + (8 * c) * 33 + n;
        v4u o; o.x = pk2(s[0 * 33], s[1 * 33]); o.y = pk2(s[2 * 33], s[3 * 33]); o.z = pk2(s[4 * 33], s[5 * 33]); o.w = pk2(s[6 * 33], s[7 * 33]);
        *(v4u*)(WT + (size_t)(n0 + n) * K + k0 + 8 * c) = o; }
    LDS_WAIT(); asm volatile("" ::: "memory");
}
__device__ __forceinline__ void rms_row_to_bf16(const float* xrow, const float* g, bf16* orow, int lane) {
    const f32x4* xr = (const f32x4*)xrow + lane; const f32x4* gr = (const f32x4*)g + lane;
    f32x4 v[4]; float s = 0.f;
#pragma unroll
    for (int j = 0; j < 4; ++j) { v[j] = xr[64 * j]; s += (v[j].x * v[j].x + v[j].y * v[j].y) + (v[j].z * v[j].z + v[j].w * v[j].w); }
    const float r = 1.f / sqrtf(wave_sum(s) * (1.f / DM) + RMS_EPS);
    v2u* o8 = (v2u*)orow + lane;
#pragma unroll
    for (int j = 0; j < 4; ++j) { const f32x4 gg = gr[64 * j]; v2u w; w.x = pk2(v[j].x * r * gg.x, v[j].y * r * gg.y); w.y = pk2(v[j].z * r * gg.z, v[j].w * r * gg.w); o8[64 * j] = w; }
}
__device__ __forceinline__ void cvt_bulk(const float* src, bf16* dst, size_t n8, size_t gtid, size_t gthreads) {
    for (size_t i = gtid; i < n8; i += gthreads) { const f32x4 a = ((const f32x4*)src)[2 * i], b = ((const f32x4*)src)[2 * i + 1];
        v4u o; o.x = pk2(a.x, a.y); o.y = pk2(a.z, a.w); o.z = pk2(b.x, b.y); o.w = pk2(b.z, b.w); ((v4u*)dst)[i] = o; }
}

template <int MODE> __device__ __forceinline__ void norm_phase(const float* xb, const float* xb2, const bf16* HBin, const bf16* O1, const float* g1, const float* g2, bf16* HBout, bf16* ACT, float* outf, int row_lo, int row_hi, int gw, int NGW, int lane) {
    for (int row = row_lo + gw; row < row_hi; row += NGW) {
        const v2u* orow = (const v2u*)(O1 + (size_t)row * DM) + lane;
        f32x4 o[4], h[4]; float s1 = 0.f;
#pragma unroll
        for (int j = 0; j < 4; ++j) { const v2u w = orow[64 * j]; o[j].x = bflo(w.x); o[j].y = bfhi(w.x); o[j].z = bflo(w.y); o[j].w = bfhi(w.y); s1 += (o[j].x * o[j].x + o[j].y * o[j].y) + (o[j].z * o[j].z + o[j].w * o[j].w); }
        if (MODE == 1) { const f32x4* xr = (const f32x4*)(row < MP ? xb + (size_t)row * DM : xb2 + (size_t)(row - MP) * DM) + lane;
#pragma unroll
            for (int j = 0; j < 4; ++j) h[j] = xr[64 * j]; }
        else { const v2u* hr = (const v2u*)(HBin + (size_t)row * DM) + lane;
#pragma unroll
            for (int j = 0; j < 4; ++j) { const v2u w = hr[64 * j]; h[j].x = bflo(w.x); h[j].y = bfhi(w.x); h[j].z = bflo(w.y); h[j].w = bfhi(w.y); } }
        const float r1 = 1.f / sqrtf(wave_sum(s1) * (1.f / DM) + RMS_EPS);
        const f32x4* g1r = (const f32x4*)g1 + lane;
        float s2 = 0.f;
#pragma unroll
        for (int j = 0; j < 4; ++j) { const f32x4 g = g1r[64 * j];
            h[j].x += o[j].x * r1 * g.x; h[j].y += o[j].y * r1 * g.y; h[j].z += o[j].z * r1 * g.z; h[j].w += o[j].w * r1 * g.w;
            s2 += (h[j].x * h[j].x + h[j].y * h[j].y) + (h[j].z * h[j].z + h[j].w * h[j].w); }
        if (MODE == 3) { f32x4* yr = (f32x4*)(outf + (size_t)row * DM) + lane;
#pragma unroll
            for (int j = 0; j < 4; ++j) yr[64 * j] = h[j]; }
        if (MODE == 1) { v2u* hb = (v2u*)(HBout + (size_t)row * DM) + lane;
#pragma unroll
            for (int j = 0; j < 4; ++j) { v2u w; w.x = pk2(h[j].x, h[j].y); w.y = pk2(h[j].z, h[j].w); hb[64 * j] = w; }
            const float r2 = 1.f / sqrtf(wave_sum(s2) * (1.f / DM) + RMS_EPS); const f32x4* g2r = (const f32x4*)g2 + lane; v2u* o8 = (v2u*)(ACT + (size_t)row * DM) + lane;
#pragma unroll
            for (int j = 0; j < 4; ++j) { const f32x4 g = g2r[64 * j]; v2u w; w.x = pk2(h[j].x * r2 * g.x, h[j].y * r2 * g.y); w.y = pk2(h[j].z * r2 * g.z, h[j].w * r2 * g.w); o8[64 * j] = w; } }
        if (MODE == 2) { v2u* o8 = (v2u*)(ACT + (size_t)row * DM) + lane;
#pragma unroll
            for (int j = 0; j < 4; ++j) { v2u w; w.x = pk2(h[j].x, h[j].y); w.y = pk2(h[j].z, h[j].w); o8[64 * j] = w; } }
    }
}

__device__ __forceinline__ void conv_phase(const bf16* Z, const float* state, const float* wconv, const float* bconv, bf16* MIX, float* out, int row_lo, int nrows, size_t gtid, size_t gthreads) {
    const size_t nitems = (size_t)nrows * 64;
    for (size_t it = gtid; it < nitems; it += gthreads) {
        const int row = row_lo + (int)(it >> 6), c0 = (int)(it & 63) * 8;
        int t, b = 0; if (row < MP) t = row; else { b = (row - MP) >> 5; t = (row - MP) & 31; }
        const bf16* zr = Z + (size_t)row * NIN;
        float zc[3][8];
#pragma unroll
        for (int j = 0; j < 3; ++j) { const int tt = t - 2 + j;
            if (tt >= 0) { const v4u cc = *(const v4u*)(zr - (size_t)(2 - j) * NIN + COL_CC + c0), cx = *(const v4u*)(zr - (size_t)(2 - j) * NIN + COL_CX + c0);
                zc[j][0] = bflo(cc.x) * bflo(cx.x); zc[j][1] = bfhi(cc.x) * bfhi(cx.x); zc[j][2] = bflo(cc.y) * bflo(cx.y); zc[j][3] = bfhi(cc.y) * bfhi(cx.y);
                zc[j][4] = bflo(cc.z) * bflo(cx.z); zc[j][5] = bfhi(cc.z) * bfhi(cx.z); zc[j][6] = bflo(cc.w) * bflo(cx.w); zc[j][7] = bfhi(cc.w) * bfhi(cx.w); }
            else if (row >= MP) { const float* sp = state + ((size_t)b * 2 + (tt + 2)) * DCONV + c0; const f32x4 a = *(const f32x4*)sp, bb = *(const f32x4*)(sp + 4);
                zc[j][0] = a.x; zc[j][1] = a.y; zc[j][2] = a.z; zc[j][3] = a.w; zc[j][4] = bb.x; zc[j][5] = bb.y; zc[j][6] = bb.z; zc[j][7] = bb.w; }
            else {
#pragma unroll
                for (int e = 0; e < 8; ++e) zc[j][e] = 0.f; } }
        const v4u cbw = *(const v4u*)(zr + COL_CB + c0);
        const float cb[8] = {bflo(cbw.x), bfhi(cbw.x), bflo(cbw.y), bfhi(cbw.y), bflo(cbw.z), bfhi(cbw.z), bflo(cbw.w), bfhi(cbw.w)};
        float y[8];
#pragma unroll
        for (int e = 0; e < 8; ++e) y[e] = cb[e] * (bconv[c0 + e] + wconv[c0 + e] * zc[0][e] + wconv[DCONV + c0 + e] * zc[1][e] + wconv[2 * DCONV + c0 + e] * zc[2][e]);
        v4u o; o.x = pk2(y[0], y[1]); o.y = pk2(y[2], y[3]); o.z = pk2(y[4], y[5]); o.w = pk2(y[6], y[7]);
        *(v4u*)(MIX + (size_t)row * DM + c0) = o;
        float* cdst = nullptr;
        if (row < MP) { if (t >= MP - 2) cdst = out + OFF_CP + (size_t)(t - (MP - 2)) * DCONV + c0; }
        else if (t >= NST - 2) cdst = out + OFF_CS + ((size_t)b * 2 + (t - (NST - 2))) * DCONV + c0;
        if (cdst) { *(f32x4*)cdst = (f32x4){zc[2][0], zc[2][1], zc[2][2], zc[2][3]}; *(f32x4*)(cdst + 4) = (f32x4){zc[2][4], zc[2][5], zc[2][6], zc[2][7]}; }
    }
}

__device__ __forceinline__ void conv_block_prompt(const bf16* Z, const float* wconv, const float* bconv, bf16* MIX, float* out, int item, int tid) {
    const int c0 = (tid & 63) * 8, r0 = item * 32 + (tid >> 6) * 4;
    float w0[8], w1[8], w2[8], bb[8];
    { const f32x4 a = *(const f32x4*)(wconv + c0), b = *(const f32x4*)(wconv + c0 + 4), c = *(const f32x4*)(wconv + DCONV + c0), d = *(const f32x4*)(wconv + DCONV + c0 + 4),
                  e = *(const f32x4*)(wconv + 2 * DCONV + c0), f = *(const f32x4*)(wconv + 2 * DCONV + c0 + 4), g = *(const f32x4*)(bconv + c0), h = *(const f32x4*)(bconv + c0 + 4);
#pragma unroll
      for (int i = 0; i < 4; ++i) { w0[i] = a[i]; w0[4 + i] = b[i]; w1[i] = c[i]; w1[4 + i] = d[i]; w2[i] = e[i]; w2[4 + i] = f[i]; bb[i] = g[i]; bb[4 + i] = h[i]; } }
    float zm2[8], zm1[8];
#define CONV_ZC(dst, row_) do { const bf16* zr_ = Z + (size_t)(row_) * NIN; const v4u cc_ = *(const v4u*)(zr_ + COL_CC + c0), cx_ = *(const v4u*)(zr_ + COL_CX + c0); \
        dst[0] = bflo(cc_.x) * bflo(cx_.x); dst[1] = bfhi(cc_.x) * bfhi(cx_.x); dst[2] = bflo(cc_.y) * bflo(cx_.y); dst[3] = bfhi(cc_.y) * bfhi(cx_.y); \
        dst[4] = bflo(cc_.z) * bflo(cx_.z); dst[5] = bfhi(cc_.z) * bfhi(cx_.z); dst[6] = bflo(cc_.w) * bflo(cx_.w); dst[7] = bfhi(cc_.w) * bfhi(cx_.w); } while (0)
    if (r0 >= 2) { CONV_ZC(zm2, r0 - 2); CONV_ZC(zm1, r0 - 1); }
    else {
#pragma unroll
        for (int e = 0; e < 8; ++e) { zm2[e] = 0.f; zm1[e] = 0.f; } }
#pragma unroll
    for (int i = 0; i < 4; ++i) { const int row = r0 + i; float z0[8]; CONV_ZC(z0, row);
        const v4u cbw = *(const v4u*)(Z + (size_t)row * NIN + COL_CB + c0);
        const float cb[8] = {bflo(cbw.x), bfhi(cbw.x), bflo(cbw.y), bfhi(cbw.y), bflo(cbw.z), bfhi(cbw.z), bflo(cbw.w), bfhi(cbw.w)};
        float y[8];
#pragma unroll
        for (int e = 0; e < 8; ++e) y[e] = cb[e] * (bb[e] + w0[e] * zm2[e] + w1[e] * zm1[e] + w2[e] * z0[e]);
        v4u o; o.x = pk2(y[0], y[1]); o.y = pk2(y[2], y[3]); o.z = pk2(y[4], y[5]); o.w = pk2(y[6], y[7]);
        *(v4u*)(MIX + (size_t)row * DM + c0) = o;
        if (row >= MP - 2) { float* cdst = out + OFF_CP + (size_t)(row - (MP - 2)) * DCONV + c0; *(f32x4*)cdst = (f32x4){z0[0], z0[1], z0[2], z0[3]}; *(f32x4*)(cdst + 4) = (f32x4){z0[4], z0[5], z0[6], z0[7]}; }
#pragma unroll
        for (int e = 0; e < 8; ++e) { zm2[e] = zm1[e]; zm1[e] = z0[e]; } }
#undef CONV_ZC
}

namespace att {
constexpr int STAGE = 32768, KOFF = 0, VOFF = 16384, NITEMS = 640;
#define MFMA32(a, b, c) __builtin_amdgcn_mfma_f32_32x32x16_bf16((a), (b), (c), 0, 0, 0)
typedef short v4i16_t __attribute__((ext_vector_type(4)));
__device__ __forceinline__ s16x4 vtr(const LAS unsigned char* p) { return __builtin_bit_cast(s16x4, __builtin_amdgcn_ds_read_tr16_b64_v4i16((LAS v4i16_t*)p)); }
#define MX3(a, b, c) __builtin_fmaxf(__builtin_fmaxf((a), (b)), (c))

struct TileSrc { const bf16* kp; const bf16* vp; const float* kf; const float* vf; int pitch; int nvalid; };
__device__ __forceinline__ TileSrc tile_src(bool sample, int head, int jb, int kt, const bf16* Z, const float* CKf, const float* CVf) {
    TileSrc t; t.kf = nullptr; t.vf = nullptr; t.kp = nullptr; t.vp = nullptr;
    if (!sample) { const bf16* r = Z + (size_t)(kt * 64) * NIN + head * 128; t.kp = r + COL_K; t.vp = r + COL_V; t.pitch = NIN; t.nvalid = 64; }
    else if (kt < PASTL / 64) { const size_t o = ((size_t)jb * PASTL + kt * 64) * 512 + head * 128; t.kf = CKf + o; t.vf = CVf + o; t.pitch = 512; t.nvalid = 64; }
    else { const bf16* r = Z + (size_t)(MP + jb * NST) * NIN + head * 128; t.kp = r + COL_K; t.vp = r + COL_V; t.pitch = NIN; t.nvalid = NST; }
    return t;
}

__device__ __forceinline__ int skip_distance(const unsigned* nrm, int h) {
    const float b0 = sqrtf(__uint_as_float(nrm[2 * h]) * __uint_as_float(nrm[8 + 2 * h])), b1 = sqrtf(__uint_as_float(nrm[2 * h + 1]) * __uint_as_float(nrm[8 + 2 * h + 1]));
    const float B = fmaxf(b0, b1) * 1.001f + 1.f; const float m2h = LOG2E * (h == 0 ? 0.25f : h == 1 ? 0.0625f : h == 2 ? 0.015625f : 0.00390625f);
    const float d = (152.f + 2.f * B) / m2h; return d < 1.0e6f ? (int)d + 1 : 1000000;
}
__device__ __forceinline__ void attn_item(LAS unsigned char* lds, volatile LAS unsigned* misc, float* PART, unsigned* pcnt, const bf16* Z, const float* CKf, const float* CVf, bf16* MIX, const float* gsub, float lam, bool sample, int head, int jb, int D, int part) {
    int tid = threadIdx.x; asm volatile("" : "+v"(tid));
    const int lane = tid & 63, r32 = lane & 31, hh = lane >> 5; const int wid = __builtin_amdgcn_readfirstlane(tid >> 6);
    const int qq = wid >> 1, mp = wid & 1;
    const int lc4 = tid & 15, lrow = tid >> 4;
    const unsigned kdst0 = KOFF + (lc4 >> 3) * 8192 + lrow * 128 + (((lc4 & 7) ^ ((lrow >> 1) & 7)) << 4);
    const unsigned vdst0 = VOFF + lrow * 256 + ((((lc4 >> 2) ^ (lrow & 3))) << 6) + ((lc4 & 3) << 4);
    const unsigned kfo = KOFF + mp * 8192 + r32 * 128;
    const int kx = (r32 >> 1) & 7;
    const int i16 = lane & 15, q4 = i16 >> 2, p4 = i16 & 3, h16 = (lane >> 4) & 1;
    const unsigned vfo = VOFF + (4 * hh + q4) * 256 + h16 * 32 + p4 * 8;
    {
        const int q0 = sample ? PASTL : jb * 128, kt_hi = sample ? (PASTL / 64) : (2 * jb + 1);
        const int nn = q0 - 63 - D; const int kt_lo = (sample || nn <= 0) ? 0 : (nn + 63) >> 6;
        const int ntall = kt_hi - kt_lo + 1;
        const int PMAXH = sample ? 1 : (head == 3 ? 4 : head == 2 ? 2 : 1);
        int P = (ntall + 63) >> 6; P = P < 1 ? 1 : (P > PMAXH ? PMAXH : P);
        if (part >= P) return;
        const int chunk = (ntall + P - 1) / P; const int t_lo = part * chunk; int t_hi = t_lo + chunk; t_hi = t_hi > ntall ? ntall : t_hi;
        const int ntiles = t_hi;
        const int qrow = sample ? (MP + jb * NST + r32) : (jb * 128 + qq * 32 + r32);
        const int qpos = sample ? (PASTL + r32) : (jb * 128 + qq * 32 + r32);
        const int kt_max = sample ? kt_hi : (2 * jb + (qq >> 1));
        const bool wactive = !(sample && qq != 0);
        const float m2 = LOG2E * (head == 0 ? 0.25f : head == 1 ? 0.0625f : head == 2 ? 0.015625f : 0.00390625f);
        bf16x8 qf[4];
#pragma unroll
        for (int s = 0; s < 4; ++s) qf[s] = *(const bf16x8*)(Z + (size_t)qrow * NIN + COL_Q + head * 128 + mp * 64 + 16 * s + 8 * hh);
        float m_run = -1e30f, l_run = 0.f;
        f32x16 O[4];
#pragma unroll
        for (int d = 0; d < 4; ++d)
#pragma unroll
            for (int i = 0; i < 16; ++i) O[d][i] = 0.f;
        if (sample) {
        f32x4 rawA[8], rawB[8];
        { const TileSrc ts = tile_src(sample, head, jb, kt_hi, Z, CKf, CVf);
#pragma unroll
          for (int p = 0; p < 2; ++p) { int row = p * 32 + lrow; row = row < ts.nvalid ? row : ts.nvalid - 1;
              rawA[p] = *(const f32x4*)(ts.kp + (size_t)row * ts.pitch + lc4 * 8); rawA[2 + p] = *(const f32x4*)(ts.vp + (size_t)row * ts.pitch + lc4 * 8); }
#pragma unroll
          for (int p = 0; p < 2; ++p) { *(LAS f32x4*)(lds + kdst0 + p * 4096) = rawA[p]; *(LAS f32x4*)(lds + vdst0 + p * 8192) = rawA[2 + p]; } }
#define SMP_LOAD(RW, tt_) do { const TileSrc ts_ = tile_src(sample, head, jb, kt_hi - (tt_), Z, CKf, CVf); \
            _Pragma("unroll") for (int p = 0; p < 2; ++p) { const int row = p * 32 + lrow; const float* kr = ts_.kf + (size_t)row * 512 + lc4 * 8; const float* vr = ts_.vf + (size_t)row * 512 + lc4 * 8; \
                RW[2 * p] = *(const f32x4*)kr; RW[2 * p + 1] = *(const f32x4*)(kr + 4); RW[4 + 2 * p] = *(const f32x4*)vr; RW[4 + 2 * p + 1] = *(const f32x4*)(vr + 4); } } while (0)
#define SMP_STORE(RW, tt_) do { const unsigned sn_ = (unsigned)((tt_) % 3) * STAGE; \
            _Pragma("unroll") for (int p = 0; p < 2; ++p) { const f32x4 a = RW[2 * p], b = RW[2 * p + 1], c = RW[4 + 2 * p], d = RW[4 + 2 * p + 1]; \
                v4u kw, vw; kw.x = pk2(a.x, a.y); kw.y = pk2(a.z, a.w); kw.z = pk2(b.x, b.y); kw.w = pk2(b.z, b.w); vw.x = pk2(c.x, c.y); vw.y = pk2(c.z, c.w); vw.z = pk2(d.x, d.y); vw.w = pk2(d.z, d.w); \
                *(LAS v4u*)(lds + sn_ + kdst0 + p * 4096) = kw; *(LAS v4u*)(lds + sn_ + vdst0 + p * 8192) = vw; } } while (0)
#define SMP_BAR() do { asm volatile("s_waitcnt lgkmcnt(0)" ::: "memory"); __builtin_amdgcn_s_barrier(); asm volatile("" ::: "memory"); } while (0)
        if (1 < ntiles) SMP_LOAD(rawA, 1);
        SMP_BAR();
        for (int t0 = 0; t0 < ntiles; t0 += 2) {
            { const int t = t0; const int kt = kt_hi - t; const unsigned so = (unsigned)(t % 3) * STAGE; const int nvalid = (kt == PASTL / 64) ? NST : 64; const int kpos0 = kt * 64;
              if (t + 2 < ntiles) SMP_LOAD(rawB, t + 2);
            if (wactive && kt <= kt_max) {
            f32x16 S0, S1;
#pragma unroll
            for (int i = 0; i < 16; ++i) { S0[i] = 0.f; S1[i] = 0.f; }
#pragma unroll
            for (int s = 0; s < 4; ++s) { const unsigned co = (unsigned)(((2 * s + hh) ^ kx) << 4);
                const bf16x8 k0 = *(const LAS bf16x8*)(lds + so + kfo + co), k1 = *(const LAS bf16x8*)(lds + so + kfo + 4096 + co);
                S0 = MFMA32(k0, qf[s], S0); S1 = MFMA32(k1, qf[s], S1); }
            const float dq = (float)(qpos - kpos0 - 4 * hh);
#pragma unroll
            for (int i = 0; i < 16; ++i) { const float c = (float)((i & 3) + 8 * (i >> 2));
                S0[i] = __builtin_fmaf(-m2, __builtin_fabsf(dq - c), S0[i]); S1[i] = __builtin_fmaf(-m2, __builtin_fabsf(dq - (c + 32.f)), S1[i]); }
            if (nvalid <= 32) {
#pragma unroll
                for (int i = 0; i < 16; ++i) S1[i] = -1e30f; }
            float mx;
            { float a = MX3(S0[0], S0[1], S1[0]), b = MX3(S0[2], S0[3], S1[1]); a = MX3(a, S1[2], S1[3]);
#pragma unroll
              for (int r = 4; r < 16; r += 4) { a = MX3(a, S0[r], S0[r + 1]); b = MX3(b, S0[r + 2], S0[r + 3]); a = MX3(a, S1[r], S1[r + 1]); b = MX3(b, S1[r + 2], S1[r + 3]); }
              mx = __builtin_fmaxf(a, b); mx = __builtin_fmaxf(mx, swap32(mx)); }
            const float m_new = __builtin_fmaxf(m_run, mx); const float alpha = __builtin_amdgcn_exp2f(m_run - m_new); m_run = m_new;
            float ls = 0.f;
#pragma unroll
            for (int i = 0; i < 16; ++i) { S0[i] = __builtin_amdgcn_exp2f(S0[i] - m_new); S1[i] = __builtin_amdgcn_exp2f(S1[i] - m_new); ls += S0[i] + S1[i]; }
            l_run = l_run * alpha + ls;
            if (__builtin_amdgcn_ballot_w64(alpha != 1.f) != 0ull) {
#pragma unroll
                for (int d = 0; d < 4; ++d)
#pragma unroll
                    for (int i = 0; i < 16; ++i) O[d][i] *= alpha; }
            bf16x8 pf[4];
            { v4u w;
              w.x = pk2(S0[0], S0[1]); w.y = pk2(S0[2], S0[3]); w.z = pk2(S0[4], S0[5]); w.w = pk2(S0[6], S0[7]); pf[0] = __builtin_bit_cast(bf16x8, w);
              w.x = pk2(S0[8], S0[9]); w.y = pk2(S0[10], S0[11]); w.z = pk2(S0[12], S0[13]); w.w = pk2(S0[14], S0[15]); pf[1] = __builtin_bit_cast(bf16x8, w);
              w.x = pk2(S1[0], S1[1]); w.y = pk2(S1[2], S1[3]); w.z = pk2(S1[4], S1[5]); w.w = pk2(S1[6], S1[7]); pf[2] = __builtin_bit_cast(bf16x8, w);
              w.x = pk2(S1[8], S1[9]); w.y = pk2(S1[10], S1[11]); w.z = pk2(S1[12], S1[13]); w.w = pk2(S1[14], S1[15]); pf[3] = __builtin_bit_cast(bf16x8, w); }
#pragma unroll
            for (int s = 0; s < 4; ++s)
#pragma unroll
                for (int d = 0; d < 4; ++d) { const unsigned vo = so + vfo + (unsigned)(16 * s) * 256 + (unsigned)((d ^ q4) << 6);
                    const s16x4 lo = vtr(lds + vo), hi = vtr(lds + vo + 8 * 256);
                    const bf16x8 vf = __builtin_shufflevector(lo, hi, 0, 1, 2, 3, 4, 5, 6, 7);
                    O[d] = MFMA32(vf, pf[s], O[d]); }
            }
              if (t + 1 < ntiles) SMP_STORE(rawA, t + 1);
              SMP_BAR(); }
            if (t0 + 1 < ntiles) { const int t = t0 + 1; const int kt = kt_hi - t; const unsigned so = (unsigned)(t % 3) * STAGE; const int nvalid = 64; const int kpos0 = kt * 64;
              if (t + 2 < ntiles) SMP_LOAD(rawA, t + 2);
            if (wactive && kt <= kt_max) {
            f32x16 S0, S1;
#pragma unroll
            for (int i = 0; i < 16; ++i) { S0[i] = 0.f; S1[i] = 0.f; }
#pragma unroll
            for (int s = 0; s < 4; ++s) { const unsigned co = (unsigned)(((2 * s + hh) ^ kx) << 4);
                const bf16x8 k0 = *(const LAS bf16x8*)(lds + so + kfo + co), k1 = *(const LAS bf16x8*)(lds + so + kfo + 4096 + co);
                S0 = MFMA32(k0, qf[s], S0); S1 = MFMA32(k1, qf[s], S1); }
            const float dq = (float)(qpos - kpos0 - 4 * hh);
#pragma unroll
            for (int i = 0; i < 16; ++i) { const float c = (float)((i & 3) + 8 * (i >> 2));
                S0[i] = __builtin_fmaf(-m2, __builtin_fabsf(dq - c), S0[i]); S1[i] = __builtin_fmaf(-m2, __builtin_fabsf(dq - (c + 32.f)), S1[i]); }
            if (nvalid <= 32) {
#pragma unroll
                for (int i = 0; i < 16; ++i) S1[i] = -1e30f; }
            float mx;
            { float a = MX3(S0[0], S0[1], S1[0]), b = MX3(S0[2], S0[3], S1[1]); a = MX3(a, S1[2], S1[3]);
#pragma unroll
              for (int r = 4; r < 16; r += 4) { a = MX3(a, S0[r], S0[r + 1]); b = MX3(b, S0[r + 2], S0[r + 3]); a = MX3(a, S1[r], S1[r + 1]); b = MX3(b, S1[r + 2], S1[r + 3]); }
              mx = __builtin_fmaxf(a, b); mx = __builtin_fmaxf(mx, swap32(mx)); }
            const float m_new = __builtin_fmaxf(m_run, mx); const float alpha = __builtin_amdgcn_exp2f(m_run - m_new); m_run = m_new;
            float ls = 0.f;
#pragma unroll
            for (int i = 0; i < 16; ++i) { S0[i] = __builtin_amdgcn_exp2f(S0[i] - m_new); S1[i] = __builtin_amdgcn_exp2f(S1[i] - m_new); ls += S0[i] + S1[i]; }
            l_run = l_run * alpha + ls;
            if (__builtin_amdgcn_ballot_w64(alpha != 1.f) != 0ull) {
#pragma unroll
                for (int d = 0; d < 4; ++d)
#pragma unroll
                    for (int i = 0; i < 16; ++i) O[d][i] *= alpha; }
            bf16x8 pf[4];
            { v4u w;
              w.x = pk2(S0[0], S0[1]); w.y = pk2(S0[2], S0[3]); w.z = pk2(S0[4], S0[5]); w.w = pk2(S0[6], S0[7]); pf[0] = __builtin_bit_cast(bf16x8, w);
              w.x = pk2(S0[8], S0[9]); w.y = pk2(S0[10], S0[11]); w.z = pk2(S0[12], S0[13]); w.w = pk2(S0[14], S0[15]); pf[1] = __builtin_bit_cast(bf16x8, w);
              w.x = pk2(S1[0], S1[1]); w.y = pk2(S1[2], S1[3]); w.z = pk2(S1[4], S1[5]); w.w = pk2(S1[6], S1[7]); pf[2] = __builtin_bit_cast(bf16x8, w);
              w.x = pk2(S1[8], S1[9]); w.y = pk2(S1[10], S1[11]); w.z = pk2(S1[12], S1[13]); w.w = pk2(S1[14], S1[15]); pf[3] = __builtin_bit_cast(bf16x8, w); }
#pragma unroll
            for (int s = 0; s < 4; ++s)
#pragma unroll
                for (int d = 0; d < 4; ++d) { const unsigned vo = so + vfo + (unsigned)(16 * s) * 256 + (unsigned)((d ^ q4) << 6);
                    const s16x4 lo = vtr(lds + vo), hi = vtr(lds + vo + 8 * 256);
                    const bf16x8 vf = __builtin_shufflevector(lo, hi, 0, 1, 2, 3, 4, 5, 6, 7);
                    O[d] = MFMA32(vf, pf[s], O[d]); }
            }
              if (t + 1 < ntiles) SMP_STORE(rawB, t + 1);
              SMP_BAR(); }
        }
#undef SMP_LOAD
#undef SMP_STORE
#undef SMP_BAR
        __syncthreads();
        } else {
            unsigned goff[4];
#pragma unroll
            for (int i = 0; i < 4; ++i) { const int b = (wid & 3) * 4 + i;
                if (wid < 4) { const int row = (b & 7) * 8 + (lane >> 3), cc = (lane & 7) ^ ((row >> 1) & 7); goff[i] = (unsigned)(row * NIN + (b >> 3) * 64 + cc * 8) * 2u; }
                else { const int row = b * 4 + (lane >> 4), p16 = lane & 15, blk = (p16 >> 2) ^ (row & 3); goff[i] = (unsigned)(row * NIN + (COL_V - COL_K) + (blk * 4 + (p16 & 3)) * 8) * 2u; } }
            const unsigned char* zb = (const unsigned char*)Z + (size_t)(head * 128 + COL_K) * 2;
            const unsigned ldsw = (unsigned)wid * 4096u;
#define ATT_ISSUE(tt_) do { const unsigned char* tb_ = zb + (size_t)(kt_hi - (tt_)) * (64 * NIN * 2); const unsigned st_ = (unsigned)(((tt_) - t_lo) & 3) * STAGE + ldsw; \
                _Pragma("unroll") for (int i_ = 0; i_ < 4; ++i_) __builtin_amdgcn_global_load_lds((const unsigned*)(tb_ + goff[i_]), (LAS unsigned*)(lds + st_ + i_ * 1024), 16, 0, 0); } while (0)
            asm volatile("s_waitcnt vmcnt(0)" ::: "memory");
            if (wid >= 4) __builtin_amdgcn_s_setprio(1);
            ATT_ISSUE(t_lo); if (t_lo + 1 < ntiles) ATT_ISSUE(t_lo + 1);
            for (int t2 = t_lo; t2 < ntiles; t2 += 2) {
                asm volatile("s_waitcnt vmcnt(0)" ::: "memory");
                __builtin_amdgcn_s_barrier();
                asm volatile("" ::: "memory");
                if (t2 + 2 < ntiles) ATT_ISSUE(t2 + 2);
                if (t2 + 3 < ntiles) ATT_ISSUE(t2 + 3);
#pragma unroll 1
                for (int t = t2; t < t2 + 2 && t < ntiles; ++t) {
                const int kt = kt_hi - t; const unsigned so = (unsigned)((t - t_lo) & 3) * STAGE; const int nvalid = 64, kpos0 = kt * 64;
            if (wactive && kt <= kt_max) {
                f32x16 S0, S1;
#pragma unroll
                for (int i = 0; i < 16; ++i) { S0[i] = 0.f; S1[i] = 0.f; }
                { bf16x8 kf[8];
#pragma unroll
                  for (int s = 0; s < 4; ++s) { const unsigned co = (unsigned)(((2 * s + hh) ^ kx) << 4);
                      kf[2 * s] = *(const LAS bf16x8*)(lds + so + kfo + co); kf[2 * s + 1] = *(const LAS bf16x8*)(lds + so + kfo + 4096 + co); }
                  __builtin_amdgcn_sched_barrier(0);
#pragma unroll
                  for (int s = 0; s < 4; ++s) { S0 = MFMA32(kf[2 * s], qf[s], S0); S1 = MFMA32(kf[2 * s + 1], qf[s], S1); } }
                const float dq = (float)(qpos - kpos0 - 4 * hh);
    #pragma unroll
                for (int i = 0; i < 16; ++i) { const float c = (float)((i & 3) + 8 * (i >> 2));
                    S0[i] = __builtin_fmaf(-m2, __builtin_fabsf(dq - c), S0[i]); S1[i] = __builtin_fmaf(-m2, __builtin_fabsf(dq - (c + 32.f)), S1[i]); }
                if (nvalid <= 32) {
    #pragma unroll
                    for (int i = 0; i < 16; ++i) S1[i] = -1e30f; }
                float mx;
                { float a = MX3(S0[0], S0[1], S1[0]), b = MX3(S0[2], S0[3], S1[1]); a = MX3(a, S1[2], S1[3]);
    #pragma unroll
                  for (int r = 4; r < 16; r += 4) { a = MX3(a, S0[r], S0[r + 1]); b = MX3(b, S0[r + 2], S0[r + 3]); a = MX3(a, S1[r], S1[r + 1]); b = MX3(b, S1[r + 2], S1[r + 3]); }
                  mx = __builtin_fmaxf(a, b); mx = __builtin_fmaxf(mx, swap32(mx)); }
                if (__builtin_amdgcn_ballot_w64(mx - m_run >= -150.f) != 0ull) {
                const float m_new = __builtin_fmaxf(m_run, mx); const float alpha = __builtin_amdgcn_exp2f(m_run - m_new); m_run = m_new;
                float ls = 0.f;
    #pragma unroll
                for (int i = 0; i < 16; ++i) { S0[i] = __builtin_amdgcn_exp2f(S0[i] - m_new); S1[i] = __builtin_amdgcn_exp2f(S1[i] - m_new); ls += S0[i] + S1[i]; }
                l_run = l_run * alpha + ls;
                if (__builtin_amdgcn_ballot_w64(alpha != 1.f) != 0ull) {
    #pragma unroll
                    for (int d = 0; d < 4; ++d)
    #pragma unroll
                        for (int i = 0; i < 16; ++i) O[d][i] *= alpha; }
                bf16x8 pf[4];
                { v4u w;
                  w.x = pk2(S0[0], S0[1]); w.y = pk2(S0[2], S0[3]); w.z = pk2(S0[4], S0[5]); w.w = pk2(S0[6], S0[7]); pf[0] = __builtin_bit_cast(bf16x8, w);
                  w.x = pk2(S0[8], S0[9]); w.y = pk2(S0[10], S0[11]); w.z = pk2(S0[12], S0[13]); w.w = pk2(S0[14], S0[15]); pf[1] = __builtin_bit_cast(bf16x8, w);
                  w.x = pk2(S1[0], S1[1]); w.y = pk2(S1[2], S1[3]); w.z = pk2(S1[4], S1[5]); w.w = pk2(S1[6], S1[7]); pf[2] = __builtin_bit_cast(bf16x8, w);
                  w.x = pk2(S1[8], S1[9]); w.y = pk2(S1[10], S1[11]); w.z = pk2(S1[12], S1[13]); w.w = pk2(S1[14], S1[15]); pf[3] = __builtin_bit_cast(bf16x8, w); }
                { s16x4 vlo[2][4], vhi[2][4];
#pragma unroll
                  for (int d = 0; d < 4; ++d) { const unsigned vo = so + vfo + (unsigned)((d ^ q4) << 6); vlo[0][d] = vtr(lds + vo); vhi[0][d] = vtr(lds + vo + 8 * 256); }
#pragma unroll
                  for (int s = 0; s < 4; ++s) {
                      if (s < 3) {
#pragma unroll
                          for (int d = 0; d < 4; ++d) { const unsigned vo = so + vfo + (unsigned)(16 * (s + 1)) * 256 + (unsigned)((d ^ q4) << 6); vlo[(s + 1) & 1][d] = vtr(lds + vo); vhi[(s + 1) & 1][d] = vtr(lds + vo + 8 * 256); } }
                      __builtin_amdgcn_sched_barrier(0);
#pragma unroll
                      for (int d = 0; d < 4; ++d) { const bf16x8 vf = __builtin_shufflevector(vlo[s & 1][d], vhi[s & 1][d], 0, 1, 2, 3, 4, 5, 6, 7); O[d] = MFMA32(vf, pf[s], O[d]); }
                      __builtin_amdgcn_sched_barrier(0); } }
                }
                }
                }
            }
#undef ATT_ISSUE
            __builtin_amdgcn_s_setprio(0);
            __syncthreads();
        }
        if (P > 1) {
            const int slot = (head == 3 ? jb * 4 : 512 + jb * 2) + part;
            float* mine = PART + ((size_t)slot * 8 + wid) * (66 * 64) + lane;
#pragma unroll
            for (int d = 0; d < 4; ++d)
#pragma unroll
                for (int i = 0; i < 16; ++i) mine[(d * 16 + i) * 64] = O[d][i];
            mine[64 * 64] = m_run; mine[65 * 64] = l_run;
            asm volatile("s_waitcnt vmcnt(0)" ::: "memory");
            __syncthreads();
            if (tid == 0) { __builtin_amdgcn_fence(__ATOMIC_RELEASE, "agent"); asm volatile("s_waitcnt vmcnt(0)" ::: "memory");
                const unsigned tk = xb_add(pcnt + (head == 3 ? jb : 128 + jb), 1u);
                if (tk == (unsigned)(P - 1)) { __builtin_amdgcn_fence(__ATOMIC_ACQUIRE, "agent"); asm volatile("s_waitcnt vmcnt(0)" ::: "memory"); }
                misc[17] = tk; }
            __syncthreads();
            const unsigned tk = misc[17];
            __syncthreads();
            if (tk != (unsigned)(P - 1)) return;
            for (int pp = 0; pp < P; ++pp) { if (pp == part) continue;
                const float* oth = PART + ((size_t)(slot - part + pp) * 8 + wid) * (66 * 64) + lane;
                const float mo = oth[64 * 64], lo = oth[65 * 64];
                const float mn = __builtin_fmaxf(m_run, mo); const float a = __builtin_amdgcn_exp2f(m_run - mn), b = __builtin_amdgcn_exp2f(mo - mn);
                m_run = mn; l_run = l_run * a + lo * b;
#pragma unroll
                for (int d = 0; d < 4; ++d)
#pragma unroll
                    for (int i = 0; i < 16; ++i) O[d][i] = O[d][i] * a + oth[(d * 16 + i) * 64] * b; }
        }
        const float lt = l_run + swap32(l_run); const float sc = (mp ? lam : 1.f) / lt;
        LAS float* X = (LAS float*)lds + qq * 4096 + lane;
        if (mp == 1 && wactive) {
#pragma unroll
            for (int d = 0; d < 4; ++d)
#pragma unroll
                for (int i = 0; i < 16; ++i) X[(d * 16 + i) * 64] = O[d][i] * sc; }
        __syncthreads();
        if (mp == 0 && wactive) {
            float ss = 0.f;
#pragma unroll
            for (int d = 0; d < 4; ++d)
#pragma unroll
                for (int i = 0; i < 16; ++i) { const float o = O[d][i] * sc - X[(d * 16 + i) * 64]; O[d][i] = o; ss += o * o; }
            ss += swap32(ss);
            const float rn = (1.f - LAM_INIT) / sqrtf(ss * (1.f / 128.f) + RMS_EPS);
            bf16* orow = MIX + (size_t)qrow * DM + 512 + head * 128 + 4 * hh;
#pragma unroll
            for (int d = 0; d < 4; ++d)
#pragma unroll
                for (int i4 = 0; i4 < 4; ++i4) { const int d0 = d * 32 + 8 * i4; const f32x4 g = *(const f32x4*)(gsub + d0 + 4 * hh);
                    v2u w; w.x = pk2(O[d][4 * i4] * rn * g.x, O[d][4 * i4 + 1] * rn * g.y); w.y = pk2(O[d][4 * i4 + 2] * rn * g.z, O[d][4 * i4 + 3] * rn * g.w);
                    *(v2u*)(orow + d0) = w; }
        }
        __syncthreads();
    }
}
__device__ __forceinline__ void qk_norm_phase(const bf16* Z, unsigned* nrm, int gw, int NGW, int lane) {
    float mq = 0.f, mk = 0.f;
    for (int row = gw; row < MP; row += NGW) {
        const v4u a = *(const v4u*)(Z + (size_t)row * NIN + COL_Q + lane * 8), b = *(const v4u*)(Z + (size_t)row * NIN + COL_K + lane * 8);
        float sq = bflo(a.x) * bflo(a.x) + bfhi(a.x) * bfhi(a.x) + bflo(a.y) * bflo(a.y) + bfhi(a.y) * bfhi(a.y) + bflo(a.z) * bflo(a.z) + bfhi(a.z) * bfhi(a.z) + bflo(a.w) * bflo(a.w) + bfhi(a.w) * bfhi(a.w);
        float sk = bflo(b.x) * bflo(b.x) + bfhi(b.x) * bfhi(b.x) + bflo(b.y) * bflo(b.y) + bfhi(b.y) * bfhi(b.y) + bflo(b.z) * bflo(b.z) + bfhi(b.z) * bfhi(b.z) + bflo(b.w) * bflo(b.w) + bfhi(b.w) * bfhi(b.w);
#pragma unroll
        for (int o = 1; o < 8; o <<= 1) { sq += __shfl_xor(sq, o); sk += __shfl_xor(sk, o); }
        mq = fmaxf(mq, sq); mk = fmaxf(mk, sk);
    }
    if ((lane & 7) == 0) { atomicMax(nrm + (lane >> 3), __float_as_uint(mq)); atomicMax(nrm + 8 + (lane >> 3), __float_as_uint(mk)); }
}
}

__global__ void __launch_bounds__(NWAVES * 64, 2) hymba_fwd(Args args) {
    extern __shared__ __attribute__((aligned(16))) unsigned char lds_raw[];
    LAS unsigned char* lds = (LAS unsigned char*)lds_raw;
    volatile LAS unsigned* MISC = (volatile LAS unsigned*)(lds + MISC_OFF);
    const int tid = threadIdx.x;
    const int G = gridDim.x, bx = blockIdx.x;
    const int vcu = (G % 8 == 0) ? (bx % 8) * (G / 8) + bx / 8 : bx;
    unsigned char* ws = args.ws;
    for (int u = tid; u < (LDS_BYTES - LDSCTL_OFF) / 4; u += NWAVES * 64) ((LAS unsigned*)(lds + LDSCTL_OFF))[u] = 0u;
    __syncthreads();
    if (args.ws == nullptr) cg::this_grid().sync();
    XcdBarrier bar = xcd_barrier_post((unsigned*)(ws + WS_CTL) + CW_BAR, MISC + 8);
    const float *x_p = args.in[0], *x_s = args.in[1], *cache_k = args.in[2], *cache_v = args.in[3], *state_conv = args.in[4], *p_p = args.in[5], *p_s = args.in[6],
                *w_in = args.in[7], *w_conv = args.in[8], *b_conv = args.in[9], *lq1 = args.in[10], *lk1 = args.in[11], *lq2 = args.in[12], *lk2 = args.in[13], *g_subln = args.in[14],
                *w_out = args.in[15], *g_pre_mix = args.in[16], *g_post_mix = args.in[17], *g_pre_mlp = args.in[18], *g_post_mlp = args.in[19], *w_up = args.in[20], *w_down = args.in[21],
                *w_pe = args.in[22], *w_g = args.in[23], *g_pe = args.in[24];
    bf16 *WinT = (bf16*)(ws + WS_WIN), *WoutT = (bf16*)(ws + WS_WOUT), *WupT = (bf16*)(ws + WS_WUP), *WdnT = (bf16*)(ws + WS_WDN), *WgT = (bf16*)(ws + WS_WG), *WpeT = (bf16*)(ws + WS_WPE);
    bf16 *ACT = (bf16*)(ws + WS_ACT), *PBF = (bf16*)(ws + WS_PBF), *PE = (bf16*)(ws + WS_PE), *Zb = (bf16*)(ws + WS_Z), *Fb = (bf16*)(ws + WS_F);
    unsigned* NRM = (unsigned*)(ws + WS_CTL) + CW_NRM;
    bf16* O1 = (bf16*)(ws + WS_O1); bf16* HB = (bf16*)(ws + WS_H1);
    const int NGW = G * NWAVES; const size_t gthreads = (size_t)G * NWAVES * 64;
#define PHASE_IDS() int tid_ = threadIdx.x; asm volatile("" : "+v"(tid_)); const int lane = tid_ & 63; const int wave = __builtin_amdgcn_readfirstlane(tid_ >> 6); const int gw = vcu * NWAVES + wave; const size_t gtid = (size_t)bx * (NWAVES * 64) + tid_; (void)gw; (void)gtid; (void)lane;

    {
        PHASE_IDS();
        LAS float* scr = (LAS float*)(lds + RING_OFF + wave * 16384);
        constexpr int I_IN = (DM / 64) * (NIN / 32), I_OUT = (DM / 64) * (DM / 32), I_UP = (DM / 64) * (DFF / 32), I_DN = (DFF / 64) * (DM / 32), I_G = I_OUT, I_PE = (PLE / 64) * (DM / 32);
        constexpr int NITEMS = I_IN + I_OUT + I_UP + I_DN + I_G + I_PE;
        for (int it = gw; it < NITEMS; it += NGW) {
            int r = it;
            if (r < I_IN) { p0_transpose_item(w_in, DM, NIN, WinT, scr, r, lane); continue; } r -= I_IN;
            if (r < I_OUT) { p0_transpose_item(w_out, DM, DM, WoutT, scr, r, lane); continue; } r -= I_OUT;
            if (r < I_UP) { p0_transpose_item(w_up, DM, DFF, WupT, scr, r, lane); continue; } r -= I_UP;
            if (r < I_DN) { p0_transpose_item(w_down, DFF, DM, WdnT, scr, r, lane); continue; } r -= I_DN;
            if (r < I_G) { p0_transpose_item(w_g, DM, DM, WgT, scr, r, lane); continue; } r -= I_G;
            p0_transpose_item(w_pe, PLE, DM, WpeT, scr, r, lane);
        }
        for (int m = gw; m < MT; m += NGW) rms_row_to_bf16(m < MP ? x_p + (size_t)m * DM : x_s + (size_t)(m - MP) * DM, g_pre_mix, ACT + (size_t)m * DM, lane);
        cvt_bulk(p_p, PBF, (size_t)MP * PLE / 8, gtid, gthreads);
        cvt_bulk(p_s, PBF + (size_t)MP * PLE, (size_t)MS * PLE / 8, gtid, gthreads);
    }
    xcd_barrier(bar);

    bf16 *ACTs = ACT + (size_t)MP * DM, *Zs = Zb + (size_t)MP * NIN, *PEs = PE + (size_t)MP * DM, *O1s = O1 + (size_t)MP * DM, *Fs = Fb + (size_t)MP * DFF, *HBs = HB + (size_t)MP * DM, *PBFs = PBF + (size_t)MP * PLE;
    unsigned* ECNT = (unsigned*)(ws + WS_CTL) + CW_ECNT;
#define GEMM_CALL(EPI, AL, SP, Aptr, Bptr, Mv, Nv, Kv, Gv, Cv, ...) do { pg8::Gemm g_{Aptr, Bptr, Mv, Nv, Kv}; pg8::StaticOrder S_; S_.init(Mv, Nv, Gv, Cv); EPI E_{__VA_ARGS__}; \
        pg8::gemm_phase<EPI, pg8::StaticOrder, AL, SP>(lds + RING_OFF, g_, S_, E_); } while (0)

    GEMM_CALL(pg8::EpiIn, PG8_ALIGN, PG8_SP2, ACT, WinT, MP, NIN, DM, G, bx, Zb, args.out + OFF_KP, args.out + OFF_VP);
    GEMM_CALL(pg8::EpiBf16<0>, false, false, PBF, WpeT, MP, DM, PLE, G, bx, PE, DM);
    xcd_barrier(bar);

    const int NSERV = (G >= 128) ? 64 : 0, GELT = G - NSERV;
    if (bx < GELT) {
        PHASE_IDS();
        att::qk_norm_phase(Zb, NRM, bx * NWAVES + wave, GELT * NWAVES, lane);
    } else {
        const int sub = bx - GELT;
        if (sub < 48) GEMM_CALL(pg8::EpiIn, PG8_ALIGN, PG8_SP2, ACTs, WinT, MS, NIN, DM, 1 << 20, sub, Zs, args.out + OFF_KS, args.out + OFF_VS);
        else GEMM_CALL(pg8::EpiBf16<0>, false, false, PBFs, WpeT, MS, DM, PLE, 1 << 20, sub - 48, PEs, DM);
    }
    for (;;) {
        PHASE_IDS();
        if (tid_ == 0) MISC[16] = atomicAdd((unsigned*)(ws + WS_CTL) + CW_QUEUE + 16, 1u);
        __syncthreads();
        const unsigned it = MISC[16];
        __syncthreads();
        if (it >= (unsigned)(MP / 32)) break;
        conv_block_prompt(Zb, w_conv, b_conv, ACT, args.out, (int)it, tid_);
    }
    if (NSERV == 0) {
        GEMM_CALL(pg8::EpiIn, PG8_ALIGN, PG8_SP2, ACTs, WinT, MS, NIN, DM, G, bx, Zs, args.out + OFF_KS, args.out + OFF_VS);
        GEMM_CALL(pg8::EpiBf16<0>, false, false, PBFs, WpeT, MS, DM, PLE, G, bx, PEs, DM);
    }
    xcd_barrier(bar);

    {
        float lam; int D0, D1, D2, D3;
        { PHASE_IDS();
          const float d1 = wave_sum(lq1[lane] * lk1[lane]), d2 = wave_sum(lq2[lane] * lk2[lane]);
          lam = __uint_as_float((unsigned)__builtin_amdgcn_readfirstlane((int)__float_as_uint(expf(d1) - expf(d2) + LAM_INIT)));
          D0 = __builtin_amdgcn_readfirstlane(att::skip_distance(NRM, 0)); D1 = __builtin_amdgcn_readfirstlane(att::skip_distance(NRM, 1));
          D2 = __builtin_amdgcn_readfirstlane(att::skip_distance(NRM, 2)); D3 = __builtin_amdgcn_readfirstlane(att::skip_distance(NRM, 3)); }
        unsigned* queue = (unsigned*)(ws + WS_CTL) + CW_QUEUE; unsigned* tmo = (unsigned*)(ws + WS_CTL) + CW_BAR + XB_TMO;
        enum { K_G1S = 0, K_PES, K_ATTP, K_CONVS, K_ATTS, K_G2S, K_N1S, K_G3S, K_G4S, K_N2S, K_G5S, K_N3S, K_END };
#define E_WAIT(kind_, need_) do { if (tid_ == 0) { XB_SPIN(xb_ld(ECNT + 64 * (kind_)) < (unsigned)(need_), (unsigned*)(ws + WS_CTL) + CW_BAR); __builtin_amdgcn_fence(__ATOMIC_ACQUIRE, "agent"); asm volatile("s_waitcnt vmcnt(0)" ::: "memory"); } __syncthreads(); } while (0)
#define E_DONE(kind_) do { asm volatile("s_waitcnt vmcnt(0)" ::: "memory"); __syncthreads(); if (tid_ == 0) { __builtin_amdgcn_fence(__ATOMIC_RELEASE, "agent"); asm volatile("s_waitcnt vmcnt(0)" ::: "memory"); (void)xb_add(ECNT + 64 * (kind_), 1u); } } while (0)
        (void)tmo;
        unsigned* aqueue = queue + 128; unsigned* PCNT = (unsigned*)(ws + WS_CTL) + 9216; float* PART = (float*)(ws + WS_PART);
        for (;;) {
            PHASE_IDS();
            if (tid_ == 0) {
                unsigned pick = 0xffffffffu;
                unsigned c = xb_ld(queue);
                if (c < 368u) { bool rdy;
                    if (c < 160u) rdy = true;
                    else if (c < 176u) rdy = xb_ld(ECNT + 64 * K_ATTS) >= 128u && xb_ld(ECNT + 64 * K_CONVS) >= 32u;
                    else if (c < 208u) rdy = xb_ld(ECNT + 64 * K_G2S) >= 16u;
                    else if (c < 272u) rdy = xb_ld(ECNT + 64 * K_N1S) >= 32u;
                    else if (c < 288u) rdy = xb_ld(ECNT + 64 * K_G3S) >= 64u;
                    else if (c < 320u) rdy = xb_ld(ECNT + 64 * K_G4S) >= 16u;
                    else if (c < 336u) rdy = xb_ld(ECNT + 64 * K_N2S) >= 32u;
                    else rdy = xb_ld(ECNT + 64 * K_G5S) >= 16u;
                    if (rdy) { c = xb_add(queue, 1u); if (c < 368u) pick = 0x10000u | c; } }
                if (pick == 0xffffffffu) { const unsigned a = xb_add(aqueue, 1u); if (a < 2048u) pick = a; }
                if (pick == 0xffffffffu) { c = xb_add(queue, 1u); if (c < 368u) pick = 0x10000u | c; }
                MISC[16] = pick;
            }
            __syncthreads();
            const unsigned pick = MISC[16];
            __syncthreads();
            int kind = K_END, sub = 0;
            if (pick != 0xffffffffu) {
                if (!(pick & 0x10000u)) { kind = K_ATTP; sub = (int)pick; }
                else { const int c = (int)(pick & 0xffffu);
                    if (c < 32) { kind = K_CONVS; sub = c; } else if (c < 160) { kind = K_ATTS; sub = c - 32; } else if (c < 176) { kind = K_G2S; sub = c - 160; } else if (c < 208) { kind = K_N1S; sub = c - 176; }
                    else if (c < 272) { kind = K_G3S; sub = c - 208; } else if (c < 288) { kind = K_G4S; sub = c - 272; } else if (c < 320) { kind = K_N2S; sub = c - 288; } else if (c < 336) { kind = K_G5S; sub = c - 320; }
                    else { kind = K_N3S; sub = c - 336; } } }
            if (kind == K_END) break;
            if (kind == K_ATTP) { const int it_ = sub >> 2, part = sub & 3;
                const int head = (it_ < 256 ? 3 : 1) - (it_ & 1), jb = 127 - ((it_ & 255) >> 1);
                att::attn_item(lds + RING_OFF, MISC, PART, PCNT, Zb, cache_k, cache_v, ACT, g_subln, lam, false, head, jb, head == 0 ? D0 : head == 1 ? D1 : head == 2 ? D2 : D3, part); }
            else if (kind == K_ATTS) { att::attn_item(lds + RING_OFF, MISC, PART, PCNT, Zb, cache_k, cache_v, ACT, g_subln, lam, true, 3 - (sub & 3), sub >> 2, 0, 0); E_DONE(K_ATTS); }
            else if (kind == K_CONVS) { conv_phase(Zb, state_conv, w_conv, b_conv, ACT, args.out, MP + sub * 32, 32, (size_t)tid_, (size_t)(NWAVES * 64)); E_DONE(K_CONVS); }
            else if (kind == K_G2S) { E_WAIT(K_ATTS, 128); E_WAIT(K_CONVS, 32); GEMM_CALL(pg8::EpiPre<0>, PG8_ALIGN, PG8_SP2, ACTs, WoutT, MS, DM, DM, 1 << 20, sub, O1s, nullptr); E_DONE(K_G2S); }
            else if (kind == K_N1S) { E_WAIT(K_G2S, 16); norm_phase<1>(x_p, x_s, nullptr, O1, g_post_mix, g_pre_mlp, HB, ACT, nullptr, MP + sub * 32, MP + sub * 32 + 32, wave, NWAVES, lane); E_DONE(K_N1S); }
            else if (kind == K_G3S) { E_WAIT(K_N1S, 32); GEMM_CALL(pg8::EpiBf16<2>, PG8_ALIGN, PG8_SP2, ACTs, WupT, MS, DFF, DM, 1 << 20, sub, Fs, DFF); E_DONE(K_G3S); }
            else if (kind == K_G4S) { E_WAIT(K_G3S, 64); GEMM_CALL(pg8::EpiPre<0>, PG8_ALIGN, PG8_SP2, Fs, WdnT, MS, DM, DFF, 1 << 20, sub, O1s, nullptr); E_DONE(K_G4S); }
            else if (kind == K_N2S) { E_WAIT(K_G4S, 16); norm_phase<2>(nullptr, nullptr, HB, O1, g_post_mlp, nullptr, nullptr, ACT, nullptr, MP + sub * 32, MP + sub * 32 + 32, wave, NWAVES, lane); E_DONE(K_N2S); }
            else if (kind == K_G5S) { E_WAIT(K_N2S, 32); GEMM_CALL(pg8::EpiPre<1>, PG8_ALIGN, PG8_SP2, ACTs, WgT, MS, DM, DM, 1 << 20, sub, O1s, PEs); E_DONE(K_G5S); }
            else { E_WAIT(K_G5S, 16); norm_phase<3>(nullptr, nullptr, ACT, O1, g_pe, nullptr, nullptr, nullptr, args.out + OFF_Y, MP + sub * 32, MP + sub * 32 + 32, wave, NWAVES, lane); }
        }
#undef E_WAIT
#undef E_DONE
    }
    xcd_barrier(bar);

    GEMM_CALL(pg8::EpiPre<0>, PG8_ALIGN, PG8_SP2, ACT, WoutT, MP, DM, DM, G, bx, O1, nullptr);
    xcd_barrier(bar);
    { PHASE_IDS(); norm_phase<1>(x_p, x_s, nullptr, O1, g_post_mix, g_pre_mlp, HB, ACT, nullptr, 0, MP, gw, NGW, lane); }
    xcd_barrier(bar);
    GEMM_CALL(pg8::EpiBf16<2>, PG8_ALIGN, PG8_SP2, ACT, WupT, MP, DFF, DM, G, bx, Fb, DFF);
    xcd_barrier(bar);
    GEMM_CALL(pg8::EpiPre<0>, PG8_ALIGN, PG8_SP2, Fb, WdnT, MP, DM, DFF, G, bx, O1, nullptr);
    xcd_barrier(bar);
    { PHASE_IDS(); norm_phase<2>(nullptr, nullptr, HB, O1, g_post_mlp, nullptr, nullptr, ACT, nullptr, 0, MP, gw, NGW, lane); }
    xcd_barrier(bar);
    GEMM_CALL(pg8::EpiPre<1>, PG8_ALIGN, PG8_SP2, ACT, WgT, MP, DM, DM, G, bx, O1, PE);
    xcd_barrier(bar);
    { PHASE_IDS(); norm_phase<3>(nullptr, nullptr, ACT, O1, g_pe, nullptr, nullptr, nullptr, args.out + OFF_Y, 0, MP, gw, NGW, lane); }
}

extern "C" void kernel_launch(void* const* d_in, const int* in_sizes, int n_in, void* d_out, int out_size, void* d_ws, size_t ws_size, hipStream_t stream) {
    static int grid = 0;
    if (grid == 0) {
        if (n_in != 25 || (size_t)out_size != OUT_TOTAL || ws_size < WS_END) { fprintf(stderr, "kernel_launch: unexpected shapes (n_in %d out %d ws %zu)\n", n_in, out_size, ws_size); grid = -1; return; }
        int dev = 0, cus = 0, per_cu = 0;
        hipGetDevice(&dev); hipDeviceGetAttribute(&cus, hipDeviceAttributeMultiprocessorCount, dev);
        hipFuncSetAttribute((const void*)hymba_fwd, hipFuncAttributeMaxDynamicSharedMemorySize, LDS_BYTES);
        hipOccupancyMaxActiveBlocksPerMultiprocessor(&per_cu, (const void*)hymba_fwd, NWAVES * 64, LDS_BYTES);
        if (per_cu < 1) { fprintf(stderr, "kernel_launch: occupancy query says %d\n", per_cu); per_cu = 1; }
        (void)hipGetLastError();
        grid = cus * 1;
    }
    if (grid < 0) return;
    hipMemsetAsync((char*)d_ws + WS_CTL, 0, CTL_ZERO_BYTES, stream);
    Args a{};
    for (int i = 0; i < 25; ++i) a.in[i] = (const float*)d_in[i];
    a.out = (float*)d_out; a.ws = (unsigned char*)d_ws;
    void* kargs[] = {&a};
    hipError_t e = hipLaunchCooperativeKernel((const void*)hymba_fwd, dim3(grid), dim3(NWAVES * 64), kargs, LDS_BYTES, stream);
    if (e != hipSuccess) fprintf(stderr, "kernel_launch: cooperative launch failed: %s (grid %d)\n", hipGetErrorString(e), grid);
}
```

```cpp
#include <hip/hip_runtime.h>
#include <hip/hip_cooperative_groups.h>
#include <cstdio>
#include <cstdint>
namespace cg = cooperative_groups;
constexpr int DM = 1024, SEQP = 16384, NSB = 32, NST = 32, PASTL = 2048, NH = 4, DCONV = 512, NIN = 3072, DFF = 4096, PLE = 256;
constexpr int MP = SEQP, MS = NSB * NST, MT = MP + MS;
constexpr int COL_CB = 0, COL_CC = 512, COL_CX = 1024, COL_Q = 1536, COL_K = 2048, COL_V = 2560;
constexpr float RMS_EPS = 1e-6f, LAM_INIT = 0.2f, LOG2E = 1.4426950408889634f, QSCALE = 0.125f * 1.4426950408889634f;
constexpr size_t OFF_Y = 0, OFF_KP = (size_t)MT * DM, OFF_VP = OFF_KP + (size_t)MP * 512, OFF_CP = OFF_VP + (size_t)MP * 512,
                 OFF_KS = OFF_CP + 2 * 512, OFF_VS = OFF_KS + (size_t)MS * 512, OFF_CS = OFF_VS + (size_t)MS * 512, OUT_TOTAL = OFF_CS + (size_t)NSB * 2 * 512;
namespace pg8 {
#define PG8_LAS __attribute__((address_space(3)))
typedef unsigned short bf16_t;
typedef short bf16x8 __attribute__((ext_vector_type(8)));
typedef float f32x4 __attribute__((ext_vector_type(4)));
typedef unsigned u32x4 __attribute__((ext_vector_type(4)));
constexpr int BM = 256, BK = 64, HALF = 128, HTB = HALF * BK * 2  , STAGE_BYTES = 8 * HTB, NXCD = 8, WGM = 8;

__host__ __device__ __forceinline__ int lds_byte(int r, int c) { const int st = (r >> 4) * 2 + (c >> 5), rr = r & 15, cc = c & 31, ob = rr * 64 + cc * 2; return st * 1024 + (ob ^ (((ob >> 9) & 1) << 5)); }
__host__ __device__ __forceinline__ void stage_rc(int b, int& R, int& C) { const int st = b / 1024, sb = b % 1024, swz = sb ^ (((sb >> 9) & 1) << 5); R = (st >> 1) * 16 + swz / 64; C = (st & 1) * 32 + (swz % 64) / 2; }
__host__ __device__ __forceinline__ int perm32(int rho) { const int n = rho >> 4, i = rho & 15; return 8 * (i >> 2) + 4 * n + (i & 3); }

struct Unit { int pm, pn; };
struct Gemm { const bf16_t* A; const bf16_t* Bt; int M, N, K; };

struct StaticOrder {
    int nM, nN, nwg, G, c;
    __host__ __device__ void init(int M, int N, int G_, int c_) { nM = M / BM; nN = N / BM; nwg = nM * nN; G = G_; c = c_; }
    __host__ __device__ bool next(int i, Unit& u) const {
        const long L = (long)i * G + c; if (L >= nwg) return false;
        int wgid = (int)L; { const int q = nwg / NXCD, r = nwg % NXCD, xcd = wgid % NXCD, off = wgid / NXCD; wgid = (xcd < r ? xcd * (q + 1) : r * (q + 1) + (xcd - r) * q) + off; }
        const int nig = WGM * nN, gid = wgid / nig, fm = gid * WGM, gsz = (nM - fm) < WGM ? (nM - fm) : WGM;
        u.pm = fm + ((wgid % nig) % gsz); u.pn = (wgid % nig) / gsz; return true;
    }
    __device__ __forceinline__ void a_ready(const Unit&) const {}
    __device__ __forceinline__ void done(const Unit&) const {}
};

__device__ __forceinline__ unsigned cvt_pk_bf16(float lo, float hi) { unsigned r; asm volatile("v_cvt_pk_bf16_f32 %0, %1, %2" : "=v"(r) : "v"(lo), "v"(hi)); return r; }
typedef float f32x2 __attribute__((ext_vector_type(2)));
typedef unsigned u32x2 __attribute__((ext_vector_type(2)));
template <int ACT> struct EpiBf16 {
    static constexpr bool PERM = true, AFTER_DRAIN = false;
    bf16_t* O; int ldc;
    __device__ __forceinline__ void operator()(const f32x4 (&acc)[2][2][4][2], const Unit& u, int wr, int wc, int fr, int fq) const {
        const int row0 = u.pm * BM + wr * 64 + fr, col0 = u.pn * BM + wc * 32 + 8 * fq;
#pragma unroll
        for (int ai = 0; ai < 2; ++ai)
#pragma unroll
            for (int m = 0; m < 4; ++m) { bf16_t* rowp = O + (size_t)(row0 + ai * HALF + m * 16) * ldc + col0;
#pragma unroll
                for (int bj = 0; bj < 2; ++bj) { f32x4 v0 = acc[ai][bj][m][0], v1 = acc[ai][bj][m][1];
                    if (ACT == 2) {
#pragma unroll
                        for (int e = 0; e < 4; ++e) { const float a = fmaxf(v0[e], 0.f), b = fmaxf(v1[e], 0.f); v0[e] = a * a; v1[e] = b * b; } }
                    u32x4 w; w.x = cvt_pk_bf16(v0[0], v0[1]); w.y = cvt_pk_bf16(v0[2], v0[3]); w.z = cvt_pk_bf16(v1[0], v1[1]); w.w = cvt_pk_bf16(v1[2], v1[3]);
                    *(u32x4*)(rowp + bj * HALF) = w; } }
    }
};
struct EpiIn {
    static constexpr bool PERM = true, AFTER_DRAIN = false;
    bf16_t* Z; float* kout; float* vout;
    __device__ __forceinline__ void operator()(const f32x4 (&acc)[2][2][4][2], const Unit& u, int wr, int wc, int fr, int fq) const {
        const int row0 = u.pm * BM + wr * 64 + fr, colt = u.pn * BM, col0 = colt + wc * 32 + 8 * fq;
        const float sc = (u.pn == 6 || u.pn == 7) ? QSCALE : 1.f;
        float* fdst = nullptr;
        if (u.pn >= 8) { const bool isv = u.pn >= 10; fdst = (isv ? vout : kout) + (colt - (isv ? COL_V : COL_K) + wc * 32 + 8 * fq); }
#pragma unroll
        for (int ai = 0; ai < 2; ++ai)
#pragma unroll
            for (int m = 0; m < 4; ++m) { const int row = row0 + ai * HALF + m * 16; bf16_t* rowp = Z + (size_t)row * NIN + col0;
#pragma unroll
                for (int bj = 0; bj < 2; ++bj) { const f32x4 a0 = acc[ai][bj][m][0], a1 = acc[ai][bj][m][1]; const f32x4 v0 = a0 * sc, v1 = a1 * sc;
                    u32x4 w; w.x = cvt_pk_bf16(v0[0], v0[1]); w.y = cvt_pk_bf16(v0[2], v0[3]); w.z = cvt_pk_bf16(v1[0], v1[1]); w.w = cvt_pk_bf16(v1[2], v1[3]);
                    *(u32x4*)(rowp + bj * HALF) = w;
                    if (fdst) { float* fp = fdst + (size_t)row * 512 + bj * HALF; *(f32x4*)fp = a0; *(f32x4*)(fp + 4) = a1; } } }
    }
};
template <int MODE> struct EpiPre {
    static constexpr bool PERM = true, AFTER_DRAIN = false;
    bf16_t* C; const bf16_t* pe;
    __device__ __forceinline__ void operator()(const f32x4 (&acc)[2][2][4][2], const Unit& u, int wr, int wc, int fr, int fq) const {
        const int row0 = u.pm * BM + wr * 64 + fr, col0 = u.pn * BM + wc * 32 + 8 * fq;
#pragma unroll
        for (int ai = 0; ai < 2; ++ai)
#pragma unroll
            for (int m = 0; m < 4; ++m) { const size_t off = (size_t)(row0 + ai * HALF + m * 16) * DM + col0;
#pragma unroll
                for (int bj = 0; bj < 2; ++bj) { f32x4 v0 = acc[ai][bj][m][0], v1 = acc[ai][bj][m][1];
                    if (MODE == 1) { const u32x4 pw = *(const u32x4*)(pe + off + bj * HALF);
                        const float p[8] = {__uint_as_float(pw.x << 16), __uint_as_float(pw.x & 0xffff0000u), __uint_as_float(pw.y << 16), __uint_as_float(pw.y & 0xffff0000u),
                                            __uint_as_float(pw.z << 16), __uint_as_float(pw.z & 0xffff0000u), __uint_as_float(pw.w << 16), __uint_as_float(pw.w & 0xffff0000u)};
#pragma unroll
                        for (int e = 0; e < 4; ++e) { v0[e] = p[e] * __builtin_amdgcn_rcpf(1.f + __builtin_amdgcn_exp2f(-LOG2E * v0[e])); v1[e] = p[4 + e] * __builtin_amdgcn_rcpf(1.f + __builtin_amdgcn_exp2f(-LOG2E * v1[e])); } }
                    u32x4 w; w.x = cvt_pk_bf16(v0[0], v0[1]); w.y = cvt_pk_bf16(v0[2], v0[3]); w.z = cvt_pk_bf16(v1[0], v1[1]); w.w = cvt_pk_bf16(v1[2], v1[3]);
                    *(u32x4*)(C + off + bj * HALF) = w; } }
    }
};
template <class Epi, class Sched, bool ALIGN_EPI = false, bool SP2 = false>
__device__ __forceinline__ void gemm_phase(PG8_LAS unsigned char* lds, const Gemm g, const Sched& S, const Epi& E) {
    int tid = threadIdx.x; asm volatile("" : "+v"(tid));
    const int wid = __builtin_amdgcn_readfirstlane(tid >> 6), lane = tid & 63, wr = wid >> 2, wc = wid & 3, fr = lane & 15, fq = lane >> 4;
    const int K = g.K, nt = K / BK;
    unsigned voffA[2], voffB[2];
#pragma unroll
    for (int i = 0; i < 2; ++i) { int R, C; stage_rc(tid * 16 + i * 8192, R, C); const int Rb = Epi::PERM ? ((R & ~31) + perm32(R & 31)) : R;
        voffA[i] = (unsigned)(R * K + C) * 2u; voffB[i] = (unsigned)(Rb * K + C) * 2u; }
    const size_t kstep = (size_t)(BK * 2);
    const size_t hstep = (size_t)HALF * K * 2;
    const size_t tstep = 2 * hstep;
    const unsigned ldsw = (unsigned)wid * 1024u;
    const int aoff = lds_byte(wr * 64 + fr, fq * 8), boff = lds_byte(wc * 32 + fr, fq * 8);
#define PG8_SA(b, h) (((b) * 2 + (h)) * HTB)
#define PG8_SB(b, h) ((4 + (b) * 2 + (h)) * HTB)
#define PG8_STAGE(bufoff, gbase, voff) do { _Pragma("unroll") for (int _i = 0; _i < 2; ++_i) \
        __builtin_amdgcn_global_load_lds((const unsigned*)((const char*)(gbase) + (voff)[_i]), (PG8_LAS unsigned*)(lds + (bufoff) + ldsw + _i * 8192), 16, 0, 0); } while (0)
#define PG8_LDA(dst, b, h) do { _Pragma("unroll") for (int m = 0; m < 4; ++m) _Pragma("unroll") for (int k = 0; k < 2; ++k) dst[m][k] = *(const PG8_LAS bf16x8*)(lds + PG8_SA(b, h) + aoff + m * 2048 + k * 1024); } while (0)
#define PG8_LDB(dst, b, h) do { _Pragma("unroll") for (int n = 0; n < 2; ++n) _Pragma("unroll") for (int k = 0; k < 2; ++k) dst[n][k] = *(const PG8_LAS bf16x8*)(lds + PG8_SB(b, h) + boff + n * 2048 + k * 1024); } while (0)
#define PG8_MMA(ai, bj, At, Bt) do { __builtin_amdgcn_s_setprio(1); _Pragma("unroll") for (int m = 0; m < 4; ++m) _Pragma("unroll") for (int n = 0; n < 2; ++n) _Pragma("unroll") for (int k = 0; k < 2; ++k) \
        acc[ai][bj][m][n] = __builtin_amdgcn_mfma_f32_16x16x32_bf16(Bt[n][k], At[m][k], acc[ai][bj][m][n], 0, 0, 0); __builtin_amdgcn_s_setprio(0); } while (0)
#define PG8_WAIT_V(n) asm volatile("s_waitcnt vmcnt(" #n ")" ::: "memory")
#define PG8_WAIT_L(n) asm volatile("s_waitcnt lgkmcnt(" #n ")" ::: "memory")
#define PG8_BAR __builtin_amdgcn_s_barrier()
#define PG8_SCHED __builtin_amdgcn_sched_barrier(0)
    Unit cur, nxt; int ui = 0;
    if (!S.next(0, cur)) return;
    f32x4 acc[2][2][4][2];
#pragma unroll
    for (int a = 0; a < 2; ++a)
#pragma unroll
        for (int b = 0; b < 2; ++b)
#pragma unroll
            for (int m = 0; m < 4; ++m)
#pragma unroll
                for (int n = 0; n < 2; ++n) acc[a][b][m][n] = (f32x4){0.f, 0.f, 0.f, 0.f};
    bf16x8 At[4][2], B0[2][2], B1[2][2];
    const char* cA = (const char*)g.A + (size_t)cur.pm * tstep; const char* cB = (const char*)g.Bt + (size_t)cur.pn * tstep;
    S.a_ready(cur);
    if constexpr (SP2) {
        PG8_STAGE(PG8_SB(0, 0), cB, voffB); PG8_STAGE(PG8_SB(0, 1), cB + hstep, voffB); PG8_STAGE(PG8_SA(0, 0), cA, voffA); PG8_STAGE(PG8_SA(0, 1), cA + hstep, voffA);
        if (wr == 1) PG8_BAR;
        PG8_WAIT_V(2); PG8_BAR;
        PG8_STAGE(PG8_SB(1, 0), cB + kstep, voffB); PG8_STAGE(PG8_SA(1, 0), cA + kstep, voffA); PG8_STAGE(PG8_SB(1, 1), cB + hstep + kstep, voffB);
        PG8_WAIT_V(6); PG8_BAR;
    } else {
        PG8_STAGE(PG8_SB(0, 0), cB, voffB); PG8_STAGE(PG8_SA(0, 0), cA, voffA); PG8_STAGE(PG8_SB(0, 1), cB + hstep, voffB); PG8_STAGE(PG8_SA(0, 1), cA + hstep, voffA);
        if (wr == 1) PG8_BAR;
        PG8_WAIT_V(4); PG8_BAR;
        PG8_STAGE(PG8_SB(1, 0), cB + kstep, voffB); PG8_STAGE(PG8_SA(1, 0), cA + kstep, voffA); PG8_STAGE(PG8_SB(1, 1), cB + hstep + kstep, voffB);
        PG8_WAIT_V(6); PG8_BAR;
    }
    for (;;) {
        const bool has_next = S.next(ui + 1, nxt);
        const char* nA = has_next ? (const char*)g.A + (size_t)nxt.pm * tstep : cA; const char* nB = has_next ? (const char*)g.Bt + (size_t)nxt.pn * tstep : cB;
        for (int t = 0; t < nt; t += 2) {
            const bool last = (t == nt - 2);
            const char* a1 = cA + (size_t)(t + 1) * kstep;
            const char* a2 = last ? nA : cA + (size_t)(t + 2) * kstep; const char* b2 = last ? nB : cB + (size_t)(t + 2) * kstep;
            const char* a3 = a2 + kstep; const char* b3 = b2 + kstep;
            if (last && has_next) S.a_ready(nxt);
            if constexpr (SP2) {
            PG8_LDB(B0, 0, 0); PG8_LDB(B1, 0, 1); PG8_SCHED; PG8_LDA(At, 0, 0); PG8_STAGE(PG8_SA(1, 1), a1 + hstep, voffA);
            PG8_WAIT_V(8); PG8_WAIT_L(0); PG8_BAR; PG8_MMA(0, 0, At, B0); PG8_MMA(0, 1, At, B1); PG8_BAR; PG8_SCHED;
            PG8_LDA(At, 0, 1); PG8_STAGE(PG8_SB(0, 0), b2, voffB); PG8_STAGE(PG8_SB(0, 1), b2 + hstep, voffB); PG8_STAGE(PG8_SA(0, 0), a2, voffA);
            PG8_WAIT_V(8); PG8_WAIT_L(0); PG8_BAR; PG8_MMA(1, 0, At, B0); PG8_MMA(1, 1, At, B1); PG8_BAR; PG8_SCHED;
            PG8_LDB(B0, 1, 0); PG8_LDB(B1, 1, 1); PG8_SCHED; PG8_LDA(At, 1, 0); PG8_STAGE(PG8_SA(0, 1), a2 + hstep, voffA);
            PG8_WAIT_V(8); PG8_WAIT_L(0); PG8_BAR; PG8_MMA(0, 0, At, B0); PG8_MMA(0, 1, At, B1); PG8_BAR; PG8_SCHED;
            PG8_LDA(At, 1, 1); PG8_STAGE(PG8_SB(1, 0), b3, voffB); PG8_STAGE(PG8_SB(1, 1), b3 + hstep, voffB); PG8_STAGE(PG8_SA(1, 0), a3, voffA);
            PG8_WAIT_V(8); PG8_WAIT_L(0); PG8_BAR; PG8_MMA(1, 0, At, B0); PG8_MMA(1, 1, At, B1); PG8_BAR; PG8_SCHED;
            } else {
            PG8_LDB(B0, 0, 0); PG8_SCHED; PG8_LDA(At, 0, 0); PG8_STAGE(PG8_SA(1, 1), a1 + hstep, voffA);
            PG8_WAIT_L(8); PG8_BAR; PG8_WAIT_L(0); PG8_MMA(0, 0, At, B0); PG8_BAR; PG8_SCHED;
            PG8_LDB(B1, 0, 1); PG8_STAGE(PG8_SB(0, 0), b2, voffB);
            PG8_BAR; PG8_WAIT_L(0); PG8_MMA(0, 1, At, B1); PG8_BAR;
            PG8_LDA(At, 0, 1); PG8_STAGE(PG8_SA(0, 0), a2, voffA);
            PG8_BAR; PG8_WAIT_L(0); PG8_MMA(1, 0, At, B0); PG8_BAR; PG8_SCHED;
            PG8_STAGE(PG8_SB(0, 1), b2 + hstep, voffB);
            PG8_WAIT_V(6); PG8_BAR; PG8_MMA(1, 1, At, B1); PG8_BAR;
            PG8_LDB(B0, 1, 0); PG8_SCHED; PG8_LDA(At, 1, 0); PG8_STAGE(PG8_SA(0, 1), a2 + hstep, voffA);
            PG8_WAIT_L(8); PG8_BAR; PG8_WAIT_L(0); PG8_MMA(0, 0, At, B0); PG8_BAR; PG8_SCHED;
            PG8_LDB(B1, 1, 1); PG8_STAGE(PG8_SB(1, 0), b3, voffB);
            PG8_BAR; PG8_WAIT_L(0); PG8_MMA(0, 1, At, B1); PG8_BAR;
            PG8_LDA(At, 1, 1); PG8_STAGE(PG8_SA(1, 0), a3, voffA);
            PG8_BAR; PG8_WAIT_L(0); PG8_MMA(1, 0, At, B0); PG8_BAR; PG8_SCHED;
            PG8_STAGE(PG8_SB(1, 1), b3 + hstep, voffB);
            PG8_WAIT_V(6); PG8_BAR; PG8_MMA(1, 1, At, B1); PG8_BAR;
            }
        }
        if constexpr (ALIGN_EPI) { if (wr == 0) PG8_BAR; }
        if constexpr (!Epi::AFTER_DRAIN) { E(acc, cur, wr, wc, fr, fq); S.done(cur); }
        if (!has_next) break;
#pragma unroll
        for (int a = 0; a < 2; ++a)
#pragma unroll
            for (int b = 0; b < 2; ++b)
#pragma unroll
                for (int m = 0; m < 4; ++m)
#pragma unroll
                    for (int n = 0; n < 2; ++n) acc[a][b][m][n] = (f32x4){0.f, 0.f, 0.f, 0.f};
        cur = nxt; cA = nA; cB = nB; ++ui;
        if constexpr (ALIGN_EPI) { if (wr == 1) PG8_BAR; }
    }
    PG8_WAIT_V(0);
    if constexpr (!ALIGN_EPI) { if (wr == 0) PG8_BAR; }
    PG8_BAR;
    if constexpr (Epi::AFTER_DRAIN) { E.fused(acc, cur, wr, wc, fr, fq, lds, wid, lane); S.done(cur); }
#undef PG8_SA
#undef PG8_SB
#undef PG8_STAGE
#undef PG8_LDA
#undef PG8_LDB
#undef PG8_MMA
#undef PG8_WAIT_V
#undef PG8_WAIT_L
#undef PG8_BAR
#undef PG8_SCHED
}
}
#define PG8_SP2 true
#define PG8_ALIGN true

constexpr size_t MiB = 1u << 20;
constexpr size_t WS_CTL = 0, CTL_ZERO_BYTES = 64 * 1024;
constexpr size_t WS_WIN = 1 * MiB, WS_WOUT = 7 * MiB, WS_WUP = 9 * MiB, WS_WDN = 17 * MiB, WS_WG = 25 * MiB, WS_WPE = 27 * MiB;
constexpr size_t WS_SSQ = 28 * MiB;
constexpr size_t WS_ACT = 30 * MiB;
constexpr size_t WS_PBF = 64 * MiB;
constexpr size_t WS_PE = 73 * MiB;
constexpr size_t WS_O1 = 107 * MiB;
constexpr size_t WS_H1 = 175 * MiB;
constexpr size_t WS_Z = 243 * MiB;
constexpr size_t WS_CK = 345 * MiB, WS_CV = 409 * MiB;
constexpr size_t WS_F = WS_Z;
constexpr size_t WS_PART = 379 * MiB;
constexpr size_t WS_END = 480 * MiB;
static_assert(WS_F + (size_t)MT * DFF * 2 <= WS_PART && WS_PART + (size_t)768 * 8 * 66 * 64 * 4 <= WS_END, "KV-split partial slots");
static_assert(WS_ACT + (size_t)MT * DM * 2 <= WS_PBF && WS_PBF + (size_t)MT * PLE * 2 <= WS_PE && WS_PE + (size_t)MT * DM * 2 <= WS_O1 && WS_O1 + (size_t)MT * DM * 4 <= WS_H1 &&
              WS_H1 + (size_t)MT * DM * 4 <= WS_Z && WS_Z + (size_t)MT * NIN * 2 <= WS_CK && WS_CK + (size_t)NSB * PASTL * 512 * 2 <= WS_CV && WS_CV + (size_t)NSB * PASTL * 512 * 2 <= WS_END && WS_F + (size_t)MT * DFF * 2 <= WS_CV && WS_SSQ + (size_t)MT * 64 <= WS_ACT, "d_ws map");
constexpr int CW_BAR = 1024, CW_QUEUE = 64, CW_NRM = 128, CW_ECNT = 8192;

constexpr int RING_OFF = 0, RING_BYTES = 131072;
constexpr int LDSCTL_OFF = RING_BYTES, MISC_OFF = LDSCTL_OFF + 320;
constexpr int LDS_BYTES = 147456;
constexpr int NWAVES = 8;

#define GAS __attribute__((address_space(1)))
#define LAS __attribute__((address_space(3)))
typedef unsigned short bf16;
typedef unsigned v4u __attribute__((ext_vector_type(4)));
typedef unsigned v2u __attribute__((ext_vector_type(2)));
typedef float f32x4 __attribute__((ext_vector_type(4)));
typedef short bf16x8 __attribute__((ext_vector_type(8)));
typedef short s16x4 __attribute__((ext_vector_type(4)));
typedef float f32x16 __attribute__((ext_vector_type(16)));
#define LDS_WAIT() asm volatile("s_waitcnt lgkmcnt(0)" ::: "memory")
__device__ __forceinline__ unsigned f2bf(float f) { unsigned u = __builtin_bit_cast(unsigned, f); return (u + 0x7fffu + ((u >> 16) & 1u)) >> 16; }
typedef __bf16 bf2_t __attribute__((ext_vector_type(2)));
typedef float f32x2_t __attribute__((ext_vector_type(2)));
__device__ __forceinline__ unsigned pk2(float lo, float hi) { const f32x2_t v = {lo, hi}; return __builtin_bit_cast(unsigned, __builtin_convertvector(v, bf2_t)); }
__device__ __forceinline__ float bflo(unsigned w) { return __uint_as_float(w << 16); }
__device__ __forceinline__ float bfhi(unsigned w) { return __uint_as_float(w & 0xffff0000u); }

#define XB_TMO      128
#define XB_XCNT(j)  (256  + 64 * (j))
#define XB_XSUB(j)  (1280 + 64 * (j))
#define XB_XGEN(j)  (2304 + 64 * (j))
#define XB_TOP      3328
#define XB_TOPGEN   3392
#define XCD_BAR_WORDS 3456
#define XB_SPIN_CAP (1u << 18)

__device__ __forceinline__ unsigned xb_ld(unsigned* p)              { return __hip_atomic_load(p, __ATOMIC_RELAXED, __HIP_MEMORY_SCOPE_AGENT); }
__device__ __forceinline__ unsigned xb_add(unsigned* p, unsigned v) { return __hip_atomic_fetch_add(p, v, __ATOMIC_RELAXED, __HIP_MEMORY_SCOPE_AGENT); }
__device__ __forceinline__ unsigned xb_xcc_id() { return (unsigned)__builtin_amdgcn_s_getreg((3 << 11) | 20) & 0xFu; }
#define XB_SPIN(cond, bar) do { unsigned _sp = 0; while (cond) { __builtin_amdgcn_s_sleep(1); \
    if ((++_sp & 255u) == 0u) { if (xb_ld(&(bar)[XB_TMO])) break; if (_sp > XB_SPIN_CAP) { atomicAdd(&(bar)[XB_TMO], 1u); break; } } } } while (0)

struct XcdBarrier {
    unsigned* bar; unsigned x;
    volatile LAS unsigned* st;
};

__device__ __forceinline__ XcdBarrier xcd_barrier_post(unsigned* bar, volatile LAS unsigned* st) {
    XcdBarrier b; b.bar = bar; b.x = xb_xcc_id(); b.st = st;
    if (threadIdx.x == 0) (void)xb_add(&bar[XB_XCNT(b.x)], 1u);
    return b;
}
__device__ __forceinline__ void xcd_barrier_complete(unsigned* bar, unsigned x, unsigned& nloc, unsigned& nx) {
    const unsigned G = gridDim.x * gridDim.y * gridDim.z;
    unsigned sum, cnt, mine, sp = 0u;
    for (;;) {
        sum = 0u; cnt = 0u; mine = 0u;
#pragma unroll
        for (unsigned j = 0; j < 16; ++j) { const unsigned c = xb_ld(&bar[XB_XCNT(j)]); sum += c; cnt += (c > 0u) ? 1u : 0u; mine = (j == x) ? c : mine; }
        if (sum == G) break;
        __builtin_amdgcn_s_sleep(1);
        if ((++sp & 255u) == 0u) { if (xb_ld(&bar[XB_TMO])) break; if (sp > XB_SPIN_CAP) { atomicAdd(&bar[XB_TMO], 1u); break; } }
    }
    nloc = mine > 0u ? mine : 1u; nx = cnt > 0u ? cnt : 1u;
}

__device__ __forceinline__ void xcd_barrier(const XcdBarrier& b) {
    asm volatile("s_waitcnt vmcnt(0)" ::: "memory");
    __syncthreads();
    if (threadIdx.x == 0) {
        unsigned* bar = b.bar;
        __builtin_amdgcn_s_waitcnt(0);
        unsigned nloc = b.st[0], nx = b.st[1];
        if (nloc == 0u) { xcd_barrier_complete(bar, b.x, nloc, nx); b.st[0] = nloc; b.st[1] = nx; }
        const unsigned old = xb_add(&bar[XB_XSUB(b.x)], 1u);
        const unsigned gen = old / nloc;
        if (old + 1u == (gen + 1u) * nloc) {
            __builtin_amdgcn_fence(__ATOMIC_RELEASE, "agent");
            asm volatile("s_waitcnt vmcnt(0)" ::: "memory");
            const unsigned og = xb_add(&bar[XB_TOP], 1u);
            const unsigned tg = og / nx;
            if (og + 1u == (tg + 1u) * nx) xb_add(&bar[XB_TOPGEN], 1u);
            else XB_SPIN(xb_ld(&bar[XB_TOPGEN]) == tg, bar);
            __builtin_amdgcn_fence(__ATOMIC_ACQUIRE, "agent");
            xb_add(&bar[XB_XGEN(b.x)], 1u);
            asm volatile("s_waitcnt vmcnt(0)" ::: "memory");
        } else {
            XB_SPIN(xb_ld(&bar[XB_XGEN(b.x)]) == gen, bar);
            __builtin_amdgcn_fence(__ATOMIC_ACQUIRE, "agent");
            asm volatile("s_waitcnt vmcnt(0)" ::: "memory");
        }
    }
    __syncthreads();
}


struct Args { const float* in[25]; float* out; unsigned char* ws; };

__device__ __forceinline__ float wave_sum(float v) {
#pragma unroll
    for (int o = 1; o < 64; o <<= 1) v += __shfl_xor(v, o);
    return v;
}
__device__ __forceinline__ float swap32(float v) { return __shfl_xor(v, 32); }

__device__ __forceinline__ void p0_transpose_item(const float* W, int K, int N, bf16* WT, LAS float* scr, int item, int lane) {
    const int nblk = N / 32, kb = item / nblk, nb = item % nblk, k0 = 64 * kb, n0 = 32 * nb;
#pragma unroll 8
    for (int i = 0; i < 32; ++i) { const int kk = 2 * i + (lane >> 5); scr[kk * 33 + (lane & 31)] = W[(size_t)(k0 + kk) * N + n0 + (lane & 31)]; }
    LDS_WAIT(); asm volatile("" ::: "memory");
    const int c = lane & 7;
#pragma unroll
    for (int j = 0; j < 4; ++j) { const int n = (lane >> 3) + 8 * j; const LAS float* s = scr + (8 * c) * 33 + n;
        v4u o; o.x = pk2(s[0 * 33], s[1 * 33]); o.y = pk2(s[2 * 33], s[3 * 33]); o.z = pk2(s[4 * 33], s[5 * 33]); o.w = pk2(s[6 * 33], s[7 * 33]);
        *(v4u*)(WT + (size_t)(n0 + n) * K + k0 + 8 * c) = o; }
    LDS_WAIT(); asm volatile("" ::: "memory");
}
__device__ __forceinline__ void rms_row_to_bf16(const float* xrow, const float* g, bf16* orow, int lane) {
    const f32x4* xr = (const f32x4*)xrow + lane; const f32x4* gr = (const f32x4*)g + lane;
    f32x4 v[4]; float s = 0.f;
#pragma unroll
    for (int j = 0; j < 4; ++j) { v[j] = xr[64 * j]; s += (v[j].x * v[j].x + v[j].y * v[j].y) + (v[j].z * v[j].z + v[j].w * v[j].w); }
    const float r = 1.f / sqrtf(wave_sum(s) * (1.f / DM) + RMS_EPS);
    v2u* o8 = (v2u*)orow + lane;
#pragma unroll
    for (int j = 0; j < 4; ++j) { const f32x4 gg = gr[64 * j]; v2u w; w.x = pk2(v[j].x * r * gg.x, v[j].y * r * gg.y); w.y = pk2(v[j].z * r * gg.z, v[j].w * r * gg.w); o8[64 * j] = w; }
}
__device__ __forceinline__ void cvt_bulk(const float* src, bf16* dst, size_t n8, size_t gtid, size_t gthreads) {
    for (size_t i = gtid; i < n8; i += gthreads) { const f32x4 a = ((const f32x4*)src)[2 * i], b = ((const f32x4*)src)[2 * i + 1];
        v4u o; o.x = pk2(a.x, a.y); o.y = pk2(a.z, a.w); o.z = pk2(b.x, b.y); o.w = pk2(b.z, b.w); ((v4u*)dst)[i] = o; }
}

template <int MODE> __device__ __forceinline__ void norm_phase(const float* xb, const float* xb2, const bf16* HBin, const bf16* O1, const float* g1, const float* g2, bf16* HBout, bf16* ACT, float* outf, int row_lo, int row_hi, int gw, int NGW, int lane) {
    for (int row = row_lo + gw; row < row_hi; row += NGW) {
        const v2u* orow = (const v2u*)(O1 + (size_t)row * DM) + lane;
        f32x4 o[4], h[4]; float s1 = 0.f;
#pragma unroll
        for (int j = 0; j < 4; ++j) { const v2u w = orow[64 * j]; o[j].x = bflo(w.x); o[j].y = bfhi(w.x); o[j].z = bflo(w.y); o[j].w = bfhi(w.y); s1 += (o[j].x * o[j].x + o[j].y * o[j].y) + (o[j].z * o[j].z + o[j].w * o[j].w); }
        if (MODE == 1) { const f32x4* xr = (const f32x4*)(row < MP ? xb + (size_t)row * DM : xb2 + (size_t)(row - MP) * DM) + lane;
#pragma unroll
            for (int j = 0; j < 4; ++j) h[j] = xr[64 * j]; }
        else { const v2u* hr = (const v2u*)(HBin + (size_t)row * DM) + lane;
#pragma unroll
            for (int j = 0; j < 4; ++j) { const v2u w = hr[64 * j]; h[j].x = bflo(w.x); h[j].y = bfhi(w.x); h[j].z = bflo(w.y); h[j].w = bfhi(w.y); } }
        const float r1 = 1.f / sqrtf(wave_sum(s1) * (1.f / DM) + RMS_EPS);
        const f32x4* g1r = (const f32x4*)g1 + lane;
        float s2 = 0.f;
#pragma unroll
        for (int j = 0; j < 4; ++j) { const f32x4 g = g1r[64 * j];
            h[j].x += o[j].x * r1 * g.x; h[j].y += o[j].y * r1 * g.y; h[j].z += o[j].z * r1 * g.z; h[j].w += o[j].w * r1 * g.w;
            s2 += (h[j].x * h[j].x + h[j].y * h[j].y) + (h[j].z * h[j].z + h[j].w * h[j].w); }
        if (MODE == 3) { f32x4* yr = (f32x4*)(outf + (size_t)row * DM) + lane;
#pragma unroll
            for (int j = 0; j < 4; ++j) yr[64 * j] = h[j]; }
        if (MODE == 1) { v2u* hb = (v2u*)(HBout + (size_t)row * DM) + lane;
#pragma unroll
            for (int j = 0; j < 4; ++j) { v2u w; w.x = pk2(h[j].x, h[j].y); w.y = pk2(h[j].z, h[j].w); hb[64 * j] = w; }
            const float r2 = 1.f / sqrtf(wave_sum(s2) * (1.f / DM) + RMS_EPS); const f32x4* g2r = (const f32x4*)g2 + lane; v2u* o8 = (v2u*)(ACT + (size_t)row * DM) + lane;
#pragma unroll
            for (int j = 0; j < 4; ++j) { const f32x4 g = g2r[64 * j]; v2u w; w.x = pk2(h[j].x * r2 * g.x, h[j].y * r2 * g.y); w.y = pk2(h[j].z * r2 * g.z, h[j].w * r2 * g.w); o8[64 * j] = w; } }
        if (MODE == 2) { v2u* o8 = (v2u*)(ACT + (size_t)row * DM) + lane;
#pragma unroll
            for (int j = 0; j < 4; ++j) { v2u w; w.x = pk2(h[j].x, h[j].y); w.y = pk2(h[j].z, h[j].w); o8[64 * j] = w; } }
    }
}

__device__ __forceinline__ void conv_phase(const bf16* Z, const float* state, const float* wconv, const float* bconv, bf16* MIX, float* out, int row_lo, int nrows, size_t gtid, size_t gthreads) {
    const size_t nitems = (size_t)nrows * 64;
    for (size_t it = gtid; it < nitems; it += gthreads) {
        const int row = row_lo + (int)(it >> 6), c0 = (int)(it & 63) * 8;
        int t, b = 0; if (row < MP) t = row; else { b = (row - MP) >> 5; t = (row - MP) & 31; }
        const bf16* zr = Z + (size_t)row * NIN;
        float zc[3][8];
#pragma unroll
        for (int j = 0; j < 3; ++j) { const int tt = t - 2 + j;
            if (tt >= 0) { const v4u cc = *(const v4u*)(zr - (size_t)(2 - j) * NIN + COL_CC + c0), cx = *(const v4u*)(zr - (size_t)(2 - j) * NIN + COL_CX + c0);
                zc[j][0] = bflo(cc.x) * bflo(cx.x); zc[j][1] = bfhi(cc.x) * bfhi(cx.x); zc[j][2] = bflo(cc.y) * bflo(cx.y); zc[j][3] = bfhi(cc.y) * bfhi(cx.y);
                zc[j][4] = bflo(cc.z) * bflo(cx.z); zc[j][5] = bfhi(cc.z) * bfhi(cx.z); zc[j][6] = bflo(cc.w) * bflo(cx.w); zc[j][7] = bfhi(cc.w) * bfhi(cx.w); }
            else if (row >= MP) { const float* sp = state + ((size_t)b * 2 + (tt + 2)) * DCONV + c0; const f32x4 a = *(const f32x4*)sp, bb = *(const f32x4*)(sp + 4);
                zc[j][0] = a.x; zc[j][1] = a.y; zc[j][2] = a.z; zc[j][3] = a.w; zc[j][4] = bb.x; zc[j][5] = bb.y; zc[j][6] = bb.z; zc[j][7] = bb.w; }
            else {
#pragma unroll
                for (int e = 0; e < 8; ++e) zc[j][e] = 0.f; } }
        const v4u cbw = *(const v4u*)(zr + COL_CB + c0);
        const float cb[8] = {bflo(cbw.x), bfhi(cbw.x), bflo(cbw.y), bfhi(cbw.y), bflo(cbw.z), bfhi(cbw.z), bflo(cbw.w), bfhi(cbw.w)};
        float y[8];
#pragma unroll
        for (int e = 0; e < 8; ++e) y[e] = cb[e] * (bconv[c0 + e] + wconv[c0 + e] * zc[0][e] + wconv[DCONV + c0 + e] * zc[1][e] + wconv[2 * DCONV + c0 + e] * zc[2][e]);
        v4u o; o.x = pk2(y[0], y[1]); o.y = pk2(y[2], y[3]); o.z = pk2(y[4], y[5]); o.w = pk2(y[6], y[7]);
        *(v4u*)(MIX + (size_t)row * DM + c0) = o;
        float* cdst = nullptr;
        if (row < MP) { if (t >= MP - 2) cdst = out + OFF_CP + (size_t)(t - (MP - 2)) * DCONV + c0; }
        else if (t >= NST - 2) cdst = out + OFF_CS + ((size_t)b * 2 + (t - (NST - 2))) * DCONV + c0;
        if (cdst) { *(f32x4*)cdst = (f32x4){zc[2][0], zc[2][1], zc[2][2], zc[2][3]}; *(f32x4*)(cdst + 4) = (f32x4){zc[2][4], zc[2][5], zc[2][6], zc[2][7]}; }
    }
}

__device__ __forceinline__ void conv_block_prompt(const bf16* Z, const float* wconv, const float* bconv, bf16* MIX, float* out, int item, int tid) {
    const int c0 = (tid & 63) * 8, r0 = item * 32 + (tid >> 6) * 4;
    float w0[8], w1[8], w2[8], bb[8];
    { const f32x4 a = *(const f32x4*)(wconv + c0), b = *(const f32x4*)(wconv + c0 + 4), c = *(const f32x4*)(wconv + DCONV + c0), d = *(const f32x4*)(wconv + DCONV + c0 + 4),
                  e = *(const f32x4*)(wconv + 2 * DCONV + c0), f = *(const f32x4*)(wconv + 2 * DCONV + c0 + 4), g = *(const f32x4*)(bconv + c0), h = *(const f32x4*)(bconv + c0 + 4);
#pragma unroll
      for (int i = 0; i < 4; ++i) { w0[i] = a[i]; w0[4 + i] = b[i]; w1[i] = c[i]; w1[4 + i] = d[i]; w2[i] = e[i]; w2[4 + i] = f[i]; bb[i] = g[i]; bb[4 + i] = h[i]; } }
    float zm2[8], zm1[8];
#define CONV_ZC(dst, row_) do { const bf16* zr_ = Z + (size_t)(row_) * NIN; const v4u cc_ = *(const v4u*)(zr_ + COL_CC + c0), cx_ = *(const v4u*)(zr_ + COL_CX + c0); \
        dst[0] = bflo(cc_.x) * bflo(cx_.x); dst[1] = bfhi(cc_.x) * bfhi(cx_.x); dst[2] = bflo(cc_.y) * bflo(cx_.y); dst[3] = bfhi(cc_.y) * bfhi(cx_.y); \
        dst[4] = bflo(cc_.z) * bflo(cx_.z); dst[5] = bfhi(cc_.z) * bfhi(cx_.z); dst[6] = bflo(cc_.w) * bflo(cx_.w); dst[7] = bfhi(cc_.w) * bfhi(cx_.w); } while (0)
    if (r0 >= 2) { CONV_ZC(zm2, r0 - 2); CONV_ZC(zm1, r0 - 1); }
    else {
#pragma unroll
        for (int e = 0; e < 8; ++e) { zm2[e] = 0.f; zm1[e] = 0.f; } }
#pragma unroll
    for (int i = 0; i < 4; ++i) { const int row = r0 + i; float z0[8]; CONV_ZC(z0, row);
        const v4u cbw = *(const v4u*)(Z + (size_t)row * NIN + COL_CB + c0);
        const float cb[8] = {bflo(cbw.x), bfhi(cbw.x), bflo(cbw.y), bfhi(cbw.y), bflo(cbw.z), bfhi(cbw.z), bflo(cbw.w), bfhi(cbw.w)};
        float y[8];
#pragma unroll
        for (int e = 0; e < 8; ++e) y[e] = cb[e] * (bb[e] + w0[e] * zm2[e] + w1[e] * zm1[e] + w2[e] * z0[e]);
        v4u o; o.x = pk2(y[0], y[1]); o.y = pk2(y[2], y[3]); o.z = pk2(y[4], y[5]); o.w = pk2(y[6], y[7]);
        *(v4u*)(MIX + (size_t)row * DM + c0) = o;
        if (row >= MP - 2) { float* cdst = out + OFF_CP + (size_t)(row - (MP - 2)) * DCONV + c0; *(f32x4*)cdst = (f32x4){z0[0], z0[1], z0[2], z0[3]}; *(f32x4*)(cdst + 4) = (f32x4){z0[4], z0[5], z0[6], z0[7]}; }
#pragma unroll
        for (int e = 0; e < 8; ++e) { zm2[e] = zm1[e]; zm1[e] = z0[e]; } }
#undef CONV_ZC
}

namespace att {
constexpr int STAGE = 32768, KOFF = 0, VOFF = 16384, NITEMS = 640;
#define MFMA32(a, b, c) __builtin_amdgcn_mfma_f32_32x32x16_bf16((a), (b), (c), 0, 0, 0)
typedef short v4i16_t __attribute__((ext_vector_type(4)));
__device__ __forceinline__ s16x4 vtr(const LAS unsigned char* p) { return __builtin_bit_cast(s16x4, __builtin_amdgcn_ds_read_tr16_b64_v4i16((LAS v4i16_t*)p)); }
#define MX3(a, b, c) __builtin_fmaxf(__builtin_fmaxf((a), (b)), (c))

struct TileSrc { const bf16* kp; const bf16* vp; const float* kf; const float* vf; int pitch; int nvalid; };
__device__ __forceinline__ TileSrc tile_src(bool sample, int head, int jb, int kt, const bf16* Z, const float* CKf, const float* CVf) {
    TileSrc t; t.kf = nullptr; t.vf = nullptr; t.kp = nullptr; t.vp = nullptr;
    if (!sample) { const bf16* r = Z + (size_t)(kt * 64) * NIN + head * 128; t.kp = r + COL_K; t.vp = r + COL_V; t.pitch = NIN; t.nvalid = 64; }
    else if (kt < PASTL / 64) { const size_t o = ((size_t)jb * PASTL + kt * 64) * 512 + head * 128; t.kf = CKf + o; t.vf = CVf + o; t.pitch = 512; t.nvalid = 64; }
    else { const bf16* r = Z + (size_t)(MP + jb * NST) * NIN + head * 128; t.kp = r + COL_K; t.vp = r + COL_V; t.pitch = NIN; t.nvalid = NST; }
    return t;
}

__device__ __forceinline__ int skip_distance(const unsigned* nrm, int h) {
    const float b0 = sqrtf(__uint_as_float(nrm[2 * h]) * __uint_as_float(nrm[8 + 2 * h])), b1 = sqrtf(__uint_as_float(nrm[2 * h + 1]) * __uint_as_float(nrm[8 + 2 * h + 1]));
    const float B = fmaxf(b0, b1) * 1.001f + 1.f; const float m2h = LOG2E * (h == 0 ? 0.25f : h == 1 ? 0.0625f : h == 2 ? 0.015625f : 0.00390625f);
    const float d = (152.f + 2.f * B) / m2h; return d < 1.0e6f ? (int)d + 1 : 1000000;
}
__device__ __forceinline__ void attn_item(LAS unsigned char* lds, volatile LAS unsigned* misc, float* PART, unsigned* pcnt, const bf16* Z, const float* CKf, const float* CVf, bf16* MIX, const float* gsub, float lam, bool sample, int head, int jb, int D, int part) {
    int tid = threadIdx.x; asm volatile("" : "+v"(tid));
    const int lane = tid & 63, r32 = lane & 31, hh = lane >> 5; const int wid = __builtin_amdgcn_readfirstlane(tid >> 6);
    const int qq = wid >> 1, mp = wid & 1;
    const int lc4 = tid & 15, lrow = tid >> 4;
    const unsigned kdst0 = KOFF + (lc4 >> 3) * 8192 + lrow * 128 + (((lc4 & 7) ^ ((lrow >> 1) & 7)) << 4);
    const unsigned vdst0 = VOFF + lrow * 256 + ((((lc4 >> 2) ^ (lrow & 3))) << 6) + ((lc4 & 3) << 4);
    const unsigned kfo = KOFF + mp * 8192 + r32 * 128;
    const int kx = (r32 >> 1) & 7;
    const int i16 = lane & 15, q4 = i16 >> 2, p4 = i16 & 3, h16 = (lane >> 4) & 1;
    const unsigned vfo = VOFF + (4 * hh + q4) * 256 + h16 * 32 + p4 * 8;
    {
        const int q0 = sample ? PASTL : jb * 128, kt_hi = sample ? (PASTL / 64) : (2 * jb + 1);
        const int nn = q0 - 63 - D; const int kt_lo = (sample || nn <= 0) ? 0 : (nn + 63) >> 6;
        const int ntall = kt_hi - kt_lo + 1;
        const int PMAXH = sample ? 1 : (head == 3 ? 4 : head == 2 ? 2 : 1);
        int P = (ntall + 63) >> 6; P = P < 1 ? 1 : (P > PMAXH ? PMAXH : P);
        if (part >= P) return;
        const int chunk = (ntall + P - 1) / P; const int t_lo = part * chunk; int t_hi = t_lo + chunk; t_hi = t_hi > ntall ? ntall : t_hi;
        const int ntiles = t_hi;
        const int qrow = sample ? (MP + jb * NST + r32) : (jb * 128 + qq * 32 + r32);
        const int qpos = sample ? (PASTL + r32) : (jb * 128 + qq * 32 + r32);
        const int kt_max = sample ? kt_hi : (2 * jb + (qq >> 1));
        const bool wactive = !(sample && qq != 0);
        const float m2 = LOG2E * (head == 0 ? 0.25f : head == 1 ? 0.0625f : head == 2 ? 0.015625f : 0.00390625f);
        bf16x8 qf[4];
#pragma unroll
        for (int s = 0; s < 4; ++s) qf[s] = *(const bf16x8*)(Z + (size_t)qrow * NIN + COL_Q + head * 128 + mp * 64 + 16 * s + 8 * hh);
        float m_run = -1e30f, l_run = 0.f;
        f32x16 O[4];
#pragma unroll
        for (int d = 0; d < 4; ++d)
#pragma unroll
            for (int i = 0; i < 16; ++i) O[d][i] = 0.f;
        if (sample) {
        f32x4 rawA[8], rawB[8];
        { const TileSrc ts = tile_src(sample, head, jb, kt_hi, Z, CKf, CVf);
#pragma unroll
          for (int p = 0; p < 2; ++p) { int row = p * 32 + lrow; row = row < ts.nvalid ? row : ts.nvalid - 1;
              rawA[p] = *(const f32x4*)(ts.kp + (size_t)row * ts.pitch + lc4 * 8); rawA[2 + p] = *(const f32x4*)(ts.vp + (size_t)row * ts.pitch + lc4 * 8); }
#pragma unroll
          for (int p = 0; p < 2; ++p) { *(LAS f32x4*)(lds + kdst0 + p * 4096) = rawA[p]; *(LAS f32x4*)(lds + vdst0 + p * 8192) = rawA[2 + p]; } }
#define SMP_LOAD(RW, tt_) do { const TileSrc ts_ = tile_src(sample, head, jb, kt_hi - (tt_), Z, CKf, CVf); \
            _Pragma("unroll") for (int p = 0; p < 2; ++p) { const int row = p * 32 + lrow; const float* kr = ts_.kf + (size_t)row * 512 + lc4 * 8; const float* vr = ts_.vf + (size_t)row * 512 + lc4 * 8; \
                RW[2 * p] = *(const f32x4*)kr; RW[2 * p + 1] = *(const f32x4*)(kr + 4); RW[4 + 2 * p] = *(const f32x4*)vr; RW[4 + 2 * p + 1] = *(const f32x4*)(vr + 4); } } while (0)
#define SMP_STORE(RW, tt_) do { const unsigned sn_ = (unsigned)((tt_) % 3) * STAGE; \
            _Pragma("unroll") for (int p = 0; p < 2; ++p) { const f32x4 a = RW[2 * p], b = RW[2 * p + 1], c = RW[4 + 2 * p], d = RW[4 + 2 * p + 1]; \
                v4u kw, vw; kw.x = pk2(a.x, a.y); kw.y = pk2(a.z, a.w); kw.z = pk2(b.x, b.y); kw.w = pk2(b.z, b.w); vw.x = pk2(c.x, c.y); vw.y = pk2(c.z, c.w); vw.z = pk2(d.x, d.y); vw.w = pk2(d.z, d.w); \
                *(LAS v4u*)(lds + sn_ + kdst0 + p * 4096) = kw; *(LAS v4u*)(lds + sn_ + vdst0 + p * 8192) = vw; } } while (0)
#define SMP_BAR() do { asm volatile("s_waitcnt lgkmcnt(0)" ::: "memory"); __builtin_amdgcn_s_barrier(); asm volatile("" ::: "memory"); } while (0)
        if (1 < ntiles) SMP_LOAD(rawA, 1);
        SMP_BAR();
        for (int t0 = 0; t0 < ntiles; t0 += 2) {
            { const int t = t0; const int kt = kt_hi - t; const unsigned so = (unsigned)(t % 3) * STAGE; const int nvalid = (kt == PASTL / 64) ? NST : 64; const int kpos0 = kt * 64;
              if (t + 2 < ntiles) SMP_LOAD(rawB, t + 2);
            if (wactive && kt <= kt_max) {
            f32x16 S0, S1;
#pragma unroll
            for (int i = 0; i < 16; ++i) { S0[i] = 0.f; S1[i] = 0.f; }
#pragma unroll
            for (int s = 0; s < 4; ++s) { const unsigned co = (unsigned)(((2 * s + hh) ^ kx) << 4);
                const bf16x8 k0 = *(const LAS bf16x8*)(lds + so + kfo + co), k1 = *(const LAS bf16x8*)(lds + so + kfo + 4096 + co);
                S0 = MFMA32(k0, qf[s], S0); S1 = MFMA32(k1, qf[s], S1); }
            const float dq = (float)(qpos - kpos0 - 4 * hh);
#pragma unroll
            for (int i = 0; i < 16; ++i) { const float c = (float)((i & 3) + 8 * (i >> 2));
                S0[i] = __builtin_fmaf(-m2, __builtin_fabsf(dq - c), S0[i]); S1[i] = __builtin_fmaf(-m2, __builtin_fabsf(dq - (c + 32.f)), S1[i]); }
            if (nvalid <= 32) {
#pragma unroll
                for (int i = 0; i < 16; ++i) S1[i] = -1e30f; }
            float mx;
            { float a = MX3(S0[0], S0[1], S1[0]), b = MX3(S0[2], S0[3], S1[1]); a = MX3(a, S1[2], S1[3]);
#pragma unroll
              for (int r = 4; r < 16; r += 4) { a = MX3(a, S0[r], S0[r + 1]); b = MX3(b, S0[r + 2], S0[r + 3]); a = MX3(a, S1[r], S1[r + 1]); b = MX3(b, S1[r + 2], S1[r + 3]); }
              mx = __builtin_fmaxf(a, b); mx = __builtin_fmaxf(mx, swap32(mx)); }
            const float m_new = __builtin_fmaxf(m_run, mx); const float alpha = __builtin_amdgcn_exp2f(m_run - m_new); m_run = m_new;
            float ls = 0.f;
#pragma unroll
            for (int i = 0; i < 16; ++i) { S0[i] = __builtin_amdgcn_exp2f(S0[i] - m_new); S1[i] = __builtin_amdgcn_exp2f(S1[i] - m_new); ls += S0[i] + S1[i]; }
            l_run = l_run * alpha + ls;
            if (__builtin_amdgcn_ballot_w64(alpha != 1.f) != 0ull) {
#pragma unroll
                for (int d = 0; d < 4; ++d)
#pragma unroll
                    for (int i = 0; i < 16; ++i) O[d][i] *= alpha; }
            bf16x8 pf[4];
            { v4u w;
              w.x = pk2(S0[0], S0[1]); w.y = pk2(S0[2], S0[3]); w.z = pk2(S0[4], S0[5]); w.w = pk2(S0[6], S0[7]); pf[0] = __builtin_bit_cast(bf16x8, w);
              w.x = pk2(S0[8], S0[9]); w.y = pk2(S0[10], S0[11]); w.z = pk2(S0[12], S0[13]); w.w = pk2(S0[14], S0[15]); pf[1] = __builtin_bit_cast(bf16x8, w);
              w.x = pk2(S1[0], S1[1]); w.y = pk2(S1[2], S1[3]); w.z = pk2(S1[4], S1[5]); w.w = pk2(S1[6], S1[7]); pf[2] = __builtin_bit_cast(bf16x8, w);
              w.x = pk2(S1[8], S1[9]); w.y = pk2(S1[10], S1[11]); w.z = pk2(S1[12], S1[13]); w.w = pk2(S1[14], S1[15]); pf[3] = __builtin_bit_cast(bf16x8, w); }
#pragma unroll
            for (int s = 0; s < 4; ++s)
#pragma unroll
                for (int d = 0; d < 4; ++d) { const unsigned vo = so + vfo + (unsigned)(16 * s) * 256 + (unsigned)((d ^ q4) << 6);
                    const s16x4 lo = vtr(lds + vo), hi = vtr(lds + vo + 8 * 256);
                    const bf16x8 vf = __builtin_shufflevector(lo, hi, 0, 1, 2, 3, 4, 5, 6, 7);
                    O[d] = MFMA32(vf, pf[s], O[d]); }
            }
              if (t + 1 < ntiles) SMP_STORE(rawA, t + 1);
              SMP_BAR(); }
            if (t0 + 1 < ntiles) { const int t = t0 + 1; const int kt = kt_hi - t; const unsigned so = (unsigned)(t % 3) * STAGE; const int nvalid = 64; const int kpos0 = kt * 64;
              if (t + 2 < ntiles) SMP_LOAD(rawA, t + 2);
            if (wactive && kt <= kt_max) {
            f32x16 S0, S1;
#pragma unroll
            for (int i = 0; i < 16; ++i) { S0[i] = 0.f; S1[i] = 0.f; }
#pragma unroll
            for (int s = 0; s < 4; ++s) { const unsigned co = (unsigned)(((2 * s + hh) ^ kx) << 4);
                const bf16x8 k0 = *(const LAS bf16x8*)(lds + so + kfo + co), k1 = *(const LAS bf16x8*)(lds + so + kfo + 4096 + co);
                S0 = MFMA32(k0, qf[s], S0); S1 = MFMA32(k1, qf[s], S1); }
            const float dq = (float)(qpos - kpos0 - 4 * hh);
#pragma unroll
            for (int i = 0; i < 16; ++i) { const float c = (float)((i & 3) + 8 * (i >> 2));
                S0[i] = __builtin_fmaf(-m2, __builtin_fabsf(dq - c), S0[i]); S1[i] = __builtin_fmaf(-m2, __builtin_fabsf(dq - (c + 32.f)), S1[i]); }
            if (nvalid <= 32) {
#pragma unroll
                for (int i = 0; i < 16; ++i) S1[i] = -1e30f; }
            float mx;
            { float a = MX3(S0[0], S0[1], S1[0]), b = MX3(S0[2], S0[3], S1[1]); a = MX3(a, S1[2], S1[3]);
#pragma unroll
              for (int r = 4; r < 16; r += 4) { a = MX3(a, S0[r], S0[r + 1]); b = MX3(b, S0[r + 2], S0[r + 3]); a = MX3(a, S1[r], S1[r + 1]); b = MX3(b, S1[r + 2], S1[r + 3]); }
              mx = __builtin_fmaxf(a, b); mx = __builtin_fmaxf(mx, swap32(mx)); }
            const float m_new = __builtin_fmaxf(m_run, mx); const float alpha = __builtin_amdgcn_exp2f(m_run - m_new); m_run = m_new;
            float ls = 0.f;
#pragma unroll
            for (int i = 0; i < 16; ++i) { S0[i] = __builtin_amdgcn_exp2f(S0[i] - m_new); S1[i] = __builtin_amdgcn_exp2f(S1[i] - m_new); ls += S0[i] + S1[i]; }
            l_run = l_run * alpha + ls;
            if (__builtin_amdgcn_ballot_w64(alpha != 1.f) != 0ull) {
#pragma unroll
                for (int d = 0; d < 4; ++d)
#pragma unroll
                    for (int i = 0; i < 16; ++i) O[d][i] *= alpha; }
            bf16x8 pf[4];
            { v4u w;
              w.x = pk2(S0[0], S0[1]); w.y = pk2(S0[2], S0[3]); w.z = pk2(S0[4], S0[5]); w.w = pk2(S0[6], S0[7]); pf[0] = __builtin_bit_cast(bf16x8, w);
              w.x = pk2(S0[8], S0[9]); w.y = pk2(S0[10], S0[11]); w.z = pk2(S0[12], S0[13]); w.w = pk2(S0[14], S0[15]); pf[1] = __builtin_bit_cast(bf16x8, w);
              w.x = pk2(S1[0], S1[1]); w.y = pk2(S1[2], S1[3]); w.z = pk2(S1[4], S1[5]); w.w = pk2(S1[6], S1[7]); pf[2] = __builtin_bit_cast(bf16x8, w);
              w.x = pk2(S1[8], S1[9]); w.y = pk2(S1[10], S1[11]); w.z = pk2(S1[12], S1[13]); w.w = pk2(S1[14], S1[15]); pf[3] = __builtin_bit_cast(bf16x8, w); }
#pragma unroll
            for (int s = 0; s < 4; ++s)
#pragma unroll
                for (int d = 0; d < 4; ++d) { const unsigned vo = so + vfo + (unsigned)(16 * s) * 256 + (unsigned)((d ^ q4) << 6);
                    const s16x4 lo = vtr(lds + vo), hi = vtr(lds + vo + 8 * 256);
                    const bf16x8 vf = __builtin_shufflevector(lo, hi, 0, 1, 2, 3, 4, 5, 6, 7);
                    O[d] = MFMA32(vf, pf[s], O[d]); }
            }
              if (t + 1 < ntiles) SMP_STORE(rawB, t + 1);
              SMP_BAR(); }
        }
#undef SMP_LOAD
#undef SMP_STORE
#undef SMP_BAR
        __syncthreads();
        } else {
            unsigned goff[4];
#pragma unroll
            for (int i = 0; i < 4; ++i) { const int b = (wid & 3) * 4 + i;
                if (wid < 4) { const int row = (b & 7) * 8 + (lane >> 3), cc = (lane & 7) ^ ((row >> 1) & 7); goff[i] = (unsigned)(row * NIN + (b >> 3) * 64 + cc * 8) * 2u; }
                else { const int row = b * 4 + (lane >> 4), p16 = lane & 15, blk = (p16 >> 2) ^ (row & 3); goff[i] = (unsigned)(row * NIN + (COL_V - COL_K) + (blk * 4 + (p16 & 3)) * 8) * 2u; } }
            const unsigned char* zb = (const unsigned char*)Z + (size_t)(head * 128 + COL_K) * 2;
            const unsigned ldsw = (unsigned)wid * 4096u;
#define ATT_ISSUE(tt_) do { const unsigned char* tb_ = zb + (size_t)(kt_hi - (tt_)) * (64 * NIN * 2); const unsigned st_ = (unsigned)(((tt_) - t_lo) & 3) * STAGE + ldsw; \
                _Pragma("unroll") for (int i_ = 0; i_ < 4; ++i_) __builtin_amdgcn_global_load_lds((const unsigned*)(tb_ + goff[i_]), (LAS unsigned*)(lds + st_ + i_ * 1024), 16, 0, 0); } while (0)
            asm volatile("s_waitcnt vmcnt(0)" ::: "memory");
            ATT_ISSUE(t_lo); if (t_lo + 1 < ntiles) ATT_ISSUE(t_lo + 1);
            for (int t2 = t_lo; t2 < ntiles; t2 += 2) {
                asm volatile("s_waitcnt vmcnt(0)" ::: "memory");
                __builtin_amdgcn_s_barrier();
                asm volatile("" ::: "memory");
                if (t2 + 2 < ntiles) ATT_ISSUE(t2 + 2);
                if (t2 + 3 < ntiles) ATT_ISSUE(t2 + 3);
#pragma unroll 1
                for (int t = t2; t < t2 + 2 && t < ntiles; ++t) {
                const int kt = kt_hi - t; const unsigned so = (unsigned)((t - t_lo) & 3) * STAGE; const int nvalid = 64, kpos0 = kt * 64;
            if (wactive && kt <= kt_max) {
                f32x16 S0, S1;
#pragma unroll
                for (int i = 0; i < 16; ++i) { S0[i] = 0.f; S1[i] = 0.f; }
                { bf16x8 kf[8];
#pragma unroll
                  for (int s = 0; s < 4; ++s) { const unsigned co = (unsigned)(((2 * s + hh) ^ kx) << 4);
                      kf[2 * s] = *(const LAS bf16x8*)(lds + so + kfo + co); kf[2 * s + 1] = *(const LAS bf16x8*)(lds + so + kfo + 4096 + co); }
                  __builtin_amdgcn_sched_barrier(0);
#pragma unroll
                  for (int s = 0; s < 4; ++s) { S0 = MFMA32(kf[2 * s], qf[s], S0); S1 = MFMA32(kf[2 * s + 1], qf[s], S1); } }
                const float dq = (float)(qpos - kpos0 - 4 * hh);
    #pragma unroll
                for (int i = 0; i < 16; ++i) { const float c = (float)((i & 3) + 8 * (i >> 2));
                    S0[i] = __builtin_fmaf(-m2, __builtin_fabsf(dq - c), S0[i]); S1[i] = __builtin_fmaf(-m2, __builtin_fabsf(dq - (c + 32.f)), S1[i]); }
                if (nvalid <= 32) {
    #pragma unroll
                    for (int i = 0; i < 16; ++i) S1[i] = -1e30f; }
                float mx;
                { float a = MX3(S0[0], S0[1], S1[0]), b = MX3(S0[2], S0[3], S1[1]); a = MX3(a, S1[2], S1[3]);
    #pragma unroll
                  for (int r = 4; r < 16; r += 4) { a = MX3(a, S0[r], S0[r + 1]); b = MX3(b, S0[r + 2], S0[r + 3]); a = MX3(a, S1[r], S1[r + 1]); b = MX3(b, S1[r + 2], S1[r + 3]); }
                  mx = __builtin_fmaxf(a, b); mx = __builtin_fmaxf(mx, swap32(mx)); }
                if (__builtin_amdgcn_ballot_w64(mx - m_run >= -150.f) != 0ull) {
                float m_new = m_run, alpha = 1.f;
                if (__builtin_amdgcn_ballot_w64(mx - m_run > 8.f) != 0ull) { m_new = __builtin_fmaxf(m_run, mx); alpha = __builtin_amdgcn_exp2f(m_run - m_new); m_run = m_new; }
                float ls = 0.f;
    #pragma unroll
                for (int i = 0; i < 16; ++i) { S0[i] = __builtin_amdgcn_exp2f(S0[i] - m_new); S1[i] = __builtin_amdgcn_exp2f(S1[i] - m_new); ls += S0[i] + S1[i]; }
                l_run = l_run * alpha + ls;
                if (__builtin_amdgcn_ballot_w64(alpha != 1.f) != 0ull) {
    #pragma unroll
                    for (int d = 0; d < 4; ++d)
    #pragma unroll
                        for (int i = 0; i < 16; ++i) O[d][i] *= alpha; }
                bf16x8 pf[4];
                { v4u w;
                  w.x = pk2(S0[0], S0[1]); w.y = pk2(S0[2], S0[3]); w.z = pk2(S0[4], S0[5]); w.w = pk2(S0[6], S0[7]); pf[0] = __builtin_bit_cast(bf16x8, w);
                  w.x = pk2(S0[8], S0[9]); w.y = pk2(S0[10], S0[11]); w.z = pk2(S0[12], S0[13]); w.w = pk2(S0[14], S0[15]); pf[1] = __builtin_bit_cast(bf16x8, w);
                  w.x = pk2(S1[0], S1[1]); w.y = pk2(S1[2], S1[3]); w.z = pk2(S1[4], S1[5]); w.w = pk2(S1[6], S1[7]); pf[2] = __builtin_bit_cast(bf16x8, w);
                  w.x = pk2(S1[8], S1[9]); w.y = pk2(S1[10], S1[11]); w.z = pk2(S1[12], S1[13]); w.w = pk2(S1[14], S1[15]); pf[3] = __builtin_bit_cast(bf16x8, w); }
                { s16x4 vlo[2][4], vhi[2][4];
#pragma unroll
                  for (int d = 0; d < 4; ++d) { const unsigned vo = so + vfo + (unsigned)((d ^ q4) << 6); vlo[0][d] = vtr(lds + vo); vhi[0][d] = vtr(lds + vo + 8 * 256); }
#pragma unroll
                  for (int s = 0; s < 4; ++s) {
                      if (s < 3) {
#pragma unroll
                          for (int d = 0; d < 4; ++d) { const unsigned vo = so + vfo + (unsigned)(16 * (s + 1)) * 256 + (unsigned)((d ^ q4) << 6); vlo[(s + 1) & 1][d] = vtr(lds + vo); vhi[(s + 1) & 1][d] = vtr(lds + vo + 8 * 256); } }
                      __builtin_amdgcn_sched_barrier(0);
#pragma unroll
                      for (int d = 0; d < 4; ++d) { const bf16x8 vf = __builtin_shufflevector(vlo[s & 1][d], vhi[s & 1][d], 0, 1, 2, 3, 4, 5, 6, 7); O[d] = MFMA32(vf, pf[s], O[d]); }
                      __builtin_amdgcn_sched_barrier(0); } }
                }
                }
                }
            }
#undef ATT_ISSUE
            __syncthreads();
        }
        if (P > 1) {
            const int slot = (head == 3 ? jb * 4 : 512 + jb * 2) + part;
            float* mine = PART + ((size_t)slot * 8 + wid) * (66 * 64) + lane;
#pragma unroll
            for (int d = 0; d < 4; ++d)
#pragma unroll
                for (int i = 0; i < 16; ++i) mine[(d * 16 + i) * 64] = O[d][i];
            mine[64 * 64] = m_run; mine[65 * 64] = l_run;
            asm volatile("s_waitcnt vmcnt(0)" ::: "memory");
            __syncthreads();
            if (tid == 0) { __builtin_amdgcn_fence(__ATOMIC_RELEASE, "agent"); asm volatile("s_waitcnt vmcnt(0)" ::: "memory");
                const unsigned tk = xb_add(pcnt + (head == 3 ? jb : 128 + jb), 1u);
                if (tk == (unsigned)(P - 1)) { __builtin_amdgcn_fence(__ATOMIC_ACQUIRE, "agent"); asm volatile("s_waitcnt vmcnt(0)" ::: "memory"); }
                misc[17] = tk; }
            __syncthreads();
            const unsigned tk = misc[17];
            __syncthreads();
            if (tk != (unsigned)(P - 1)) return;
            for (int pp = 0; pp < P; ++pp) { if (pp == part) continue;
                const float* oth = PART + ((size_t)(slot - part + pp) * 8 + wid) * (66 * 64) + lane;
                const float mo = oth[64 * 64], lo = oth[65 * 64];
                const float mn = __builtin_fmaxf(m_run, mo); const float a = __builtin_amdgcn_exp2f(m_run - mn), b = __builtin_amdgcn_exp2f(mo - mn);
                m_run = mn; l_run = l_run * a + lo * b;
#pragma unroll
                for (int d = 0; d < 4; ++d)
#pragma unroll
                    for (int i = 0; i < 16; ++i) O[d][i] = O[d][i] * a + oth[(d * 16 + i) * 64] * b; }
        }
        const float lt = l_run + swap32(l_run); const float sc = (mp ? lam : 1.f) / lt;
        LAS float* X = (LAS float*)lds + qq * 4096 + lane;
        if (mp == 1 && wactive) {
#pragma unroll
            for (int d = 0; d < 4; ++d)
#pragma unroll
                for (int i = 0; i < 16; ++i) X[(d * 16 + i) * 64] = O[d][i] * sc; }
        __syncthreads();
        if (mp == 0 && wactive) {
            float ss = 0.f;
#pragma unroll
            for (int d = 0; d < 4; ++d)
#pragma unroll
                for (int i = 0; i < 16; ++i) { const float o = O[d][i] * sc - X[(d * 16 + i) * 64]; O[d][i] = o; ss += o * o; }
            ss += swap32(ss);
            const float rn = (1.f - LAM_INIT) / sqrtf(ss * (1.f / 128.f) + RMS_EPS);
            bf16* orow = MIX + (size_t)qrow * DM + 512 + head * 128 + 4 * hh;
#pragma unroll
            for (int d = 0; d < 4; ++d)
#pragma unroll
                for (int i4 = 0; i4 < 4; ++i4) { const int d0 = d * 32 + 8 * i4; const f32x4 g = *(const f32x4*)(gsub + d0 + 4 * hh);
                    v2u w; w.x = pk2(O[d][4 * i4] * rn * g.x, O[d][4 * i4 + 1] * rn * g.y); w.y = pk2(O[d][4 * i4 + 2] * rn * g.z, O[d][4 * i4 + 3] * rn * g.w);
                    *(v2u*)(orow + d0) = w; }
        }
        __syncthreads();
    }
}
__device__ __forceinline__ void qk_norm_phase(const bf16* Z, unsigned* nrm, int gw, int NGW, int lane) {
    float mq = 0.f, mk = 0.f;
    for (int row = gw; row < MP; row += NGW) {
        const v4u a = *(const v4u*)(Z + (size_t)row * NIN + COL_Q + lane * 8), b = *(const v4u*)(Z + (size_t)row * NIN + COL_K + lane * 8);
        float sq = bflo(a.x) * bflo(a.x) + bfhi(a.x) * bfhi(a.x) + bflo(a.y) * bflo(a.y) + bfhi(a.y) * bfhi(a.y) + bflo(a.z) * bflo(a.z) + bfhi(a.z) * bfhi(a.z) + bflo(a.w) * bflo(a.w) + bfhi(a.w) * bfhi(a.w);
        float sk = bflo(b.x) * bflo(b.x) + bfhi(b.x) * bfhi(b.x) + bflo(b.y) * bflo(b.y) + bfhi(b.y) * bfhi(b.y) + bflo(b.z) * bflo(b.z) + bfhi(b.z) * bfhi(b.z) + bflo(b.w) * bflo(b.w) + bfhi(b.w) * bfhi(b.w);
#pragma unroll
        for (int o = 1; o < 8; o <<= 1) { sq += __shfl_xor(sq, o); sk += __shfl_xor(sk, o); }
        mq = fmaxf(mq, sq); mk = fmaxf(mk, sk);
    }
    if ((lane & 7) == 0) { atomicMax(nrm + (lane >> 3), __float_as_uint(mq)); atomicMax(nrm + 8 + (lane >> 3), __float_as_uint(mk)); }
}
}

__global__ void __launch_bounds__(NWAVES * 64, 2) hymba_fwd(Args args) {
    extern __shared__ __attribute__((aligned(16))) unsigned char lds_raw[];
    LAS unsigned char* lds = (LAS unsigned char*)lds_raw;
    volatile LAS unsigned* MISC = (volatile LAS unsigned*)(lds + MISC_OFF);
    const int tid = threadIdx.x;
    const int G = gridDim.x, bx = blockIdx.x;
    const int vcu = (G % 8 == 0) ? (bx % 8) * (G / 8) + bx / 8 : bx;
    unsigned char* ws = args.ws;
    for (int u = tid; u < (LDS_BYTES - LDSCTL_OFF) / 4; u += NWAVES * 64) ((LAS unsigned*)(lds + LDSCTL_OFF))[u] = 0u;
    __syncthreads();
    if (args.ws == nullptr) cg::this_grid().sync();
    XcdBarrier bar = xcd_barrier_post((unsigned*)(ws + WS_CTL) + CW_BAR, MISC + 8);
    const float *x_p = args.in[0], *x_s = args.in[1], *cache_k = args.in[2], *cache_v = args.in[3], *state_conv = args.in[4], *p_p = args.in[5], *p_s = args.in[6],
                *w_in = args.in[7], *w_conv = args.in[8], *b_conv = args.in[9], *lq1 = args.in[10], *lk1 = args.in[11], *lq2 = args.in[12], *lk2 = args.in[13], *g_subln = args.in[14],
                *w_out = args.in[15], *g_pre_mix = args.in[16], *g_post_mix = args.in[17], *g_pre_mlp = args.in[18], *g_post_mlp = args.in[19], *w_up = args.in[20], *w_down = args.in[21],
                *w_pe = args.in[22], *w_g = args.in[23], *g_pe = args.in[24];
    bf16 *WinT = (bf16*)(ws + WS_WIN), *WoutT = (bf16*)(ws + WS_WOUT), *WupT = (bf16*)(ws + WS_WUP), *WdnT = (bf16*)(ws + WS_WDN), *WgT = (bf16*)(ws + WS_WG), *WpeT = (bf16*)(ws + WS_WPE);
    bf16 *ACT = (bf16*)(ws + WS_ACT), *PBF = (bf16*)(ws + WS_PBF), *PE = (bf16*)(ws + WS_PE), *Zb = (bf16*)(ws + WS_Z), *Fb = (bf16*)(ws + WS_F);
    unsigned* NRM = (unsigned*)(ws + WS_CTL) + CW_NRM;
    bf16* O1 = (bf16*)(ws + WS_O1); bf16* HB = (bf16*)(ws + WS_H1);
    const int NGW = G * NWAVES; const size_t gthreads = (size_t)G * NWAVES * 64;
#define PHASE_IDS() int tid_ = threadIdx.x; asm volatile("" : "+v"(tid_)); const int lane = tid_ & 63; const int wave = __builtin_amdgcn_readfirstlane(tid_ >> 6); const int gw = vcu * NWAVES + wave; const size_t gtid = (size_t)bx * (NWAVES * 64) + tid_; (void)gw; (void)gtid; (void)lane;

    {
        PHASE_IDS();
        LAS float* scr = (LAS float*)(lds + RING_OFF + wave * 16384);
        constexpr int I_IN = (DM / 64) * (NIN / 32), I_OUT = (DM / 64) * (DM / 32), I_UP = (DM / 64) * (DFF / 32), I_DN = (DFF / 64) * (DM / 32), I_G = I_OUT, I_PE = (PLE / 64) * (DM / 32);
        constexpr int NITEMS = I_IN + I_OUT + I_UP + I_DN + I_G + I_PE;
        for (int it = gw; it < NITEMS; it += NGW) {
            int r = it;
            if (r < I_IN) { p0_transpose_item(w_in, DM, NIN, WinT, scr, r, lane); continue; } r -= I_IN;
            if (r < I_OUT) { p0_transpose_item(w_out, DM, DM, WoutT, scr, r, lane); continue; } r -= I_OUT;
            if (r < I_UP) { p0_transpose_item(w_up, DM, DFF, WupT, scr, r, lane); continue; } r -= I_UP;
            if (r < I_DN) { p0_transpose_item(w_down, DFF, DM, WdnT, scr, r, lane); continue; } r -= I_DN;
            if (r < I_G) { p0_transpose_item(w_g, DM, DM, WgT, scr, r, lane); continue; } r -= I_G;
            p0_transpose_item(w_pe, PLE, DM, WpeT, scr, r, lane);
        }
        for (int m = gw; m < MT; m += NGW) rms_row_to_bf16(m < MP ? x_p + (size_t)m * DM : x_s + (size_t)(m - MP) * DM, g_pre_mix, ACT + (size_t)m * DM, lane);
        cvt_bulk(p_p, PBF, (size_t)MP * PLE / 8, gtid, gthreads);
        cvt_bulk(p_s, PBF + (size_t)MP * PLE, (size_t)MS * PLE / 8, gtid, gthreads);
    }
    xcd_barrier(bar);

    bf16 *ACTs = ACT + (size_t)MP * DM, *Zs = Zb + (size_t)MP * NIN, *PEs = PE + (size_t)MP * DM, *O1s = O1 + (size_t)MP * DM, *Fs = Fb + (size_t)MP * DFF, *HBs = HB + (size_t)MP * DM, *PBFs = PBF + (size_t)MP * PLE;
    unsigned* ECNT = (unsigned*)(ws + WS_CTL) + CW_ECNT;
#define GEMM_CALL(EPI, AL, SP, Aptr, Bptr, Mv, Nv, Kv, Gv, Cv, ...) do { pg8::Gemm g_{Aptr, Bptr, Mv, Nv, Kv}; pg8::StaticOrder S_; S_.init(Mv, Nv, Gv, Cv); EPI E_{__VA_ARGS__}; \
        pg8::gemm_phase<EPI, pg8::StaticOrder, AL, SP>(lds + RING_OFF, g_, S_, E_); } while (0)

    GEMM_CALL(pg8::EpiIn, PG8_ALIGN, PG8_SP2, ACT, WinT, MP, NIN, DM, G, bx, Zb, args.out + OFF_KP, args.out + OFF_VP);
    GEMM_CALL(pg8::EpiBf16<0>, false, false, PBF, WpeT, MP, DM, PLE, G, bx, PE, DM);
    xcd_barrier(bar);

    const int NSERV = (G >= 128) ? 64 : 0, GELT = G - NSERV;
    if (bx < GELT) {
        PHASE_IDS();
        att::qk_norm_phase(Zb, NRM, bx * NWAVES + wave, GELT * NWAVES, lane);
    } else {
        const int sub = bx - GELT;
        if (sub < 48) GEMM_CALL(pg8::EpiIn, PG8_ALIGN, PG8_SP2, ACTs, WinT, MS, NIN, DM, 1 << 20, sub, Zs, args.out + OFF_KS, args.out + OFF_VS);
        else GEMM_CALL(pg8::EpiBf16<0>, false, false, PBFs, WpeT, MS, DM, PLE, 1 << 20, sub - 48, PEs, DM);
    }
    for (;;) {
        PHASE_IDS();
        if (tid_ == 0) MISC[16] = atomicAdd((unsigned*)(ws + WS_CTL) + CW_QUEUE + 16, 1u);
        __syncthreads();
        const unsigned it = MISC[16];
        __syncthreads();
        if (it >= (unsigned)(MP / 32)) break;
        conv_block_prompt(Zb, w_conv, b_conv, ACT, args.out, (int)it, tid_);
    }
    if (NSERV == 0) {
        GEMM_CALL(pg8::EpiIn, PG8_ALIGN, PG8_SP2, ACTs, WinT, MS, NIN, DM, G, bx, Zs, args.out + OFF_KS, args.out + OFF_VS);
        GEMM_CALL(pg8::EpiBf16<0>, false, false, PBFs, WpeT, MS, DM, PLE, G, bx, PEs, DM);
    }
    xcd_barrier(bar);

    {
        float lam; int D0, D1, D2, D3;
        { PHASE_IDS();
          const float d1 = wave_sum(lq1[lane] * lk1[lane]), d2 = wave_sum(lq2[lane] * lk2[lane]);
          lam = __uint_as_float((unsigned)__builtin_amdgcn_readfirstlane((int)__float_as_uint(expf(d1) - expf(d2) + LAM_INIT)));
          D0 = __builtin_amdgcn_readfirstlane(att::skip_distance(NRM, 0)); D1 = __builtin_amdgcn_readfirstlane(att::skip_distance(NRM, 1));
          D2 = __builtin_amdgcn_readfirstlane(att::skip_distance(NRM, 2)); D3 = __builtin_amdgcn_readfirstlane(att::skip_distance(NRM, 3)); }
        unsigned* queue = (unsigned*)(ws + WS_CTL) + CW_QUEUE; unsigned* tmo = (unsigned*)(ws + WS_CTL) + CW_BAR + XB_TMO;
        enum { K_G1S = 0, K_PES, K_ATTP, K_CONVS, K_ATTS, K_G2S, K_N1S, K_G3S, K_G4S, K_N2S, K_G5S, K_N3S, K_END };
#define E_WAIT(kind_, need_) do { if (tid_ == 0) { XB_SPIN(xb_ld(ECNT + 64 * (kind_)) < (unsigned)(need_), (unsigned*)(ws + WS_CTL) + CW_BAR); __builtin_amdgcn_fence(__ATOMIC_ACQUIRE, "agent"); asm volatile("s_waitcnt vmcnt(0)" ::: "memory"); } __syncthreads(); } while (0)
#define E_DONE(kind_) do { asm volatile("s_waitcnt vmcnt(0)" ::: "memory"); __syncthreads(); if (tid_ == 0) { __builtin_amdgcn_fence(__ATOMIC_RELEASE, "agent"); asm volatile("s_waitcnt vmcnt(0)" ::: "memory"); (void)xb_add(ECNT + 64 * (kind_), 1u); } } while (0)
        (void)tmo;
        unsigned* aqueue = queue + 128; unsigned* PCNT = (unsigned*)(ws + WS_CTL) + 9216; float* PART = (float*)(ws + WS_PART);
        for (;;) {
            PHASE_IDS();
            if (tid_ == 0) {
                unsigned pick = 0xffffffffu;
                unsigned c = xb_ld(queue);
                if (c < 368u) { bool rdy;
                    if (c < 160u) rdy = true;
                    else if (c < 176u) rdy = xb_ld(ECNT + 64 * K_ATTS) >= 128u && xb_ld(ECNT + 64 * K_CONVS) >= 32u;
                    else if (c < 208u) rdy = xb_ld(ECNT + 64 * K_G2S) >= 16u;
                    else if (c < 272u) rdy = xb_ld(ECNT + 64 * K_N1S) >= 32u;
                    else if (c < 288u) rdy = xb_ld(ECNT + 64 * K_G3S) >= 64u;
                    else if (c < 320u) rdy = xb_ld(ECNT + 64 * K_G4S) >= 16u;
                    else if (c < 336u) rdy = xb_ld(ECNT + 64 * K_N2S) >= 32u;
                    else rdy = xb_ld(ECNT + 64 * K_G5S) >= 16u;
                    if (rdy) { c = xb_add(queue, 1u); if (c < 368u) pick = 0x10000u | c; } }
                if (pick == 0xffffffffu) { const unsigned a = xb_add(aqueue, 1u); if (a < 2048u) pick = a; }
                if (pick == 0xffffffffu) { c = xb_add(queue, 1u); if (c < 368u) pick = 0x10000u | c; }
                MISC[16] = pick;
            }
            __syncthreads();
            const unsigned pick = MISC[16];
            __syncthreads();
            int kind = K_END, sub = 0;
            if (pick != 0xffffffffu) {
                if (!(pick & 0x10000u)) { kind = K_ATTP; sub = (int)pick; }
                else { const int c = (int)(pick & 0xffffu);
                    if (c < 32) { kind = K_CONVS; sub = c; } else if (c < 160) { kind = K_ATTS; sub = c - 32; } else if (c < 176) { kind = K_G2S; sub = c - 160; } else if (c < 208) { kind = K_N1S; sub = c - 176; }
                    else if (c < 272) { kind = K_G3S; sub = c - 208; } else if (c < 288) { kind = K_G4S; sub = c - 272; } else if (c < 320) { kind = K_N2S; sub = c - 288; } else if (c < 336) { kind = K_G5S; sub = c - 320; }
                    else { kind = K_N3S; sub = c - 336; } } }
            if (kind == K_END) break;
            if (kind == K_ATTP) { const int it_ = sub >> 2, part = sub & 3;
                const int head = (it_ < 256 ? 3 : 1) - (it_ & 1), jb = 127 - ((it_ & 255) >> 1);
                att::attn_item(lds + RING_OFF, MISC, PART, PCNT, Zb, cache_k, cache_v, ACT, g_subln, lam, false, head, jb, head == 0 ? D0 : head == 1 ? D1 : head == 2 ? D2 : D3, part); }
            else if (kind == K_ATTS) { att::attn_item(lds + RING_OFF, MISC, PART, PCNT, Zb, cache_k, cache_v, ACT, g_subln, lam, true, 3 - (sub & 3), sub >> 2, 0, 0); E_DONE(K_ATTS); }
            else if (kind == K_CONVS) { conv_phase(Zb, state_conv, w_conv, b_conv, ACT, args.out, MP + sub * 32, 32, (size_t)tid_, (size_t)(NWAVES * 64)); E_DONE(K_CONVS); }
            else if (kind == K_G2S) { E_WAIT(K_ATTS, 128); E_WAIT(K_CONVS, 32); GEMM_CALL(pg8::EpiPre<0>, PG8_ALIGN, PG8_SP2, ACTs, WoutT, MS, DM, DM, 1 << 20, sub, O1s, nullptr); E_DONE(K_G2S); }
            else if (kind == K_N1S) { E_WAIT(K_G2S, 16); norm_phase<1>(x_p, x_s, nullptr, O1, g_post_mix, g_pre_mlp, HB, ACT, nullptr, MP + sub * 32, MP + sub * 32 + 32, wave, NWAVES, lane); E_DONE(K_N1S); }
            else if (kind == K_G3S) { E_WAIT(K_N1S, 32); GEMM_CALL(pg8::EpiBf16<2>, PG8_ALIGN, PG8_SP2, ACTs, WupT, MS, DFF, DM, 1 << 20, sub, Fs, DFF); E_DONE(K_G3S); }
            else if (kind == K_G4S) { E_WAIT(K_G3S, 64); GEMM_CALL(pg8::EpiPre<0>, PG8_ALIGN, PG8_SP2, Fs, WdnT, MS, DM, DFF, 1 << 20, sub, O1s, nullptr); E_DONE(K_G4S); }
            else if (kind == K_N2S) { E_WAIT(K_G4S, 16); norm_phase<2>(nullptr, nullptr, HB, O1, g_post_mlp, nullptr, nullptr, ACT, nullptr, MP + sub * 32, MP + sub * 32 + 32, wave, NWAVES, lane); E_DONE(K_N2S); }
            else if (kind == K_G5S) { E_WAIT(K_N2S, 32); GEMM_CALL(pg8::EpiPre<1>, PG8_ALIGN, PG8_SP2, ACTs, WgT, MS, DM, DM, 1 << 20, sub, O1s, PEs); E_DONE(K_G5S); }
            else { E_WAIT(K_G5S, 16); norm_phase<3>(nullptr, nullptr, ACT, O1, g_pe, nullptr, nullptr, nullptr, args.out + OFF_Y, MP + sub * 32, MP + sub * 32 + 32, wave, NWAVES, lane); }
        }
#undef E_WAIT
#undef E_DONE
    }
    xcd_barrier(bar);

    GEMM_CALL(pg8::EpiPre<0>, PG8_ALIGN, PG8_SP2, ACT, WoutT, MP, DM, DM, G, bx, O1, nullptr);
    xcd_barrier(bar);
    { PHASE_IDS(); norm_phase<1>(x_p, x_s, nullptr, O1, g_post_mix, g_pre_mlp, HB, ACT, nullptr, 0, MP, gw, NGW, lane); }
    xcd_barrier(bar);
    GEMM_CALL(pg8::EpiBf16<2>, PG8_ALIGN, PG8_SP2, ACT, WupT, MP, DFF, DM, G, bx, Fb, DFF);
    xcd_barrier(bar);
    GEMM_CALL(pg8::EpiPre<0>, PG8_ALIGN, PG8_SP2, Fb, WdnT, MP, DM, DFF, G, bx, O1, nullptr);
    xcd_barrier(bar);
    { PHASE_IDS(); norm_phase<2>(nullptr, nullptr, HB, O1, g_post_mlp, nullptr, nullptr, ACT, nullptr, 0, MP, gw, NGW, lane); }
    xcd_barrier(bar);
    GEMM_CALL(pg8::EpiPre<1>, PG8_ALIGN, PG8_SP2, ACT, WgT, MP, DM, DM, G, bx, O1, PE);
    xcd_barrier(bar);
    { PHASE_IDS(); norm_phase<3>(nullptr, nullptr, ACT, O1, g_pe, nullptr, nullptr, nullptr, args.out + OFF_Y, 0, MP, gw, NGW, lane); }
}

extern "C" void kernel_launch(void* const* d_in, const int* in_sizes, int n_in, void* d_out, int out_size, void* d_ws, size_t ws_size, hipStream_t stream) {
    static int grid = 0;
    if (grid == 0) {
        if (n_in != 25 || (size_t)out_size != OUT_TOTAL || ws_size < WS_END) { fprintf(stderr, "kernel_launch: unexpected shapes (n_in %d out %d ws %zu)\n", n_in, out_size, ws_size); grid = -1; return; }
        int dev = 0, cus = 0, per_cu = 0;
        hipGetDevice(&dev); hipDeviceGetAttribute(&cus, hipDeviceAttributeMultiprocessorCount, dev);
        hipFuncSetAttribute((const void*)hymba_fwd, hipFuncAttributeMaxDynamicSharedMemorySize, LDS_BYTES);
        hipOccupancyMaxActiveBlocksPerMultiprocessor(&per_cu, (const void*)hymba_fwd, NWAVES * 64, LDS_BYTES);
        if (per_cu < 1) { fprintf(stderr, "kernel_launch: occupancy query says %d\n", per_cu); per_cu = 1; }
        (void)hipGetLastError();
        grid = cus * 1;
    }
    if (grid < 0) return;
    hipMemsetAsync((char*)d_ws + WS_CTL, 0, CTL_ZERO_BYTES, stream);
    Args a{};
    for (int i = 0; i < 25; ++i) a.in[i] = (const float*)d_in[i];
    a.out = (float*)d_out; a.ws = (unsigned char*)d_ws;
    void* kargs[] = {&a};
    hipError_t e = hipLaunchCooperativeKernel((const void*)hymba_fwd, dim3(grid), dim3(NWAVES * 64), kargs, LDS_BYTES, stream);
    if (e != hipSuccess) fprintf(stderr, "kernel_launch: cooperative launch failed: %s (grid %d)\n", hipGetErrorString(e), grid);
}
```
